# Optimizing an MI355X kernel written in HIP

```python
import functools
import math
import jax
import jax.numpy as jnp
from jax import lax
import numpy as np

D_MODEL = 1024
BATCH = 2
SEQ = 8192
DEPTH = 4

GRID_W = 64
CTX_LEN = 256
N_EVEN = (DEPTH + 1) // 2
N_ODD = DEPTH // 2
EPS = 1e-6
ROPE_BASE = 10000.0
F32 = jnp.float32

S5_WIDTH = D_MODEL // 2
S5_GROUP = 16
S5_GROUPS = S5_WIDTH // S5_GROUP
S5_STATE = 64

MLA_HEADS = 8
MLA_NOPE = 64
MLA_ROPE = 32
MLA_V = 64
MLA_Q_RANK = D_MODEL // 4
MLA_KV_RANK = D_MODEL // 8
ATT_BLOCK = 128

EVEN_SIZES = (S5_WIDTH, MLA_Q_RANK, MLA_KV_RANK, MLA_ROPE)
EVEN_IN = sum(EVEN_SIZES)
EVEN_MIX = S5_WIDTH + MLA_HEADS * MLA_V

RET_HEADS = 4
RET_DK = 128
RET_DV = 128
RET_CHUNK = 128
RET_QK = RET_HEADS * RET_DK
RET_VW = RET_HEADS * RET_DV
RET_DECAY_OFFSETS = (0.0, 0.5)

HG_HEADS = 4
HG_DK = 128
HG_DV = 128
HG_CHUNK = 64
HG_QK = HG_HEADS * HG_DK
HG_VW = HG_HEADS * HG_DV

ODD_SIZES = (RET_QK, RET_QK, RET_VW, RET_VW, HG_QK, HG_QK, HG_QK, HG_VW, HG_VW)
ODD_IN = sum(ODD_SIZES)
ODD_MIX = RET_VW + HG_VW

D_FF = -(-8 * D_MODEL // (3 * 256)) * 256

kernel_name = 'hybrid_s5_mla_retention_hgrn2_diffusion_trunk'


def rms_norm(x, g):
    xf = x.astype(F32)
    y = xf * lax.rsqrt(jnp.mean(xf * xf, axis=-1, keepdims=True) + EPS)
    return (y * g.astype(F32)).astype(x.dtype)


def split_heads(t, n_heads):
    b, l, w = t.shape
    return t.reshape(b, l, n_heads, w // n_heads).transpose(0, 2, 1, 3)


def merge_heads(t):
    b, h, l, d = t.shape
    return t.transpose(0, 2, 1, 3).reshape(b, l, h * d)


def head_norm(o, g, center):
    of = o.astype(F32)
    if center:
        of = of - jnp.mean(of, axis=-1, keepdims=True)
    of = of * lax.rsqrt(jnp.mean(of * of, axis=-1, keepdims=True) + EPS)
    return (merge_heads(of) * g.astype(F32)).astype(o.dtype)


def split_cols(t, sizes):
    idx = []
    s = 0
    for n in sizes[:-1]:
        s += n
        idx.append(s)
    return jnp.split(t, idx, axis=-1)


def axial_rope(rows, dim):
    r, col = jnp.meshgrid(jnp.arange(rows, dtype=F32), jnp.arange(GRID_W, dtype=F32), indexing='ij')
    quarter = dim // 4
    inv = ROPE_BASE ** (-jnp.arange(quarter, dtype=F32) / quarter)
    ang = jnp.concatenate([r.reshape(-1, 1) * inv, col.reshape(-1, 1) * inv], axis=-1)
    return jnp.cos(ang), jnp.sin(ang)


def apply_rope(x, cos, sin):
    xp = x.reshape(x.shape[:-1] + (x.shape[-1] // 2, 2))
    x1, x2 = xp[..., 0], xp[..., 1]
    cos = cos.astype(x.dtype)
    sin = sin.astype(x.dtype)
    return jnp.stack([x1 * cos - x2 * sin, x1 * sin + x2 * cos], axis=-1).reshape(x.shape)


def swiglu(h, w1, w3, w2):
    return (jax.nn.silu(h @ w1) * (h @ w3)) @ w2


def context_then_latent(dir_fn, ctx_in, lat_in, s0, axis, reverse):
    flip = (lambda t: jnp.flip(t, axis)) if reverse else (lambda t: t)
    o_c, s_c = dir_fn(*[flip(t) for t in ctx_in], s0)
    o_x, _ = dir_fn(*[flip(t) for t in lat_in], s_c)
    return flip(o_x), flip(o_c)


def block_attention(q, k, v):
    b, h, lq, d = q.shape
    nb = lq // ATT_BLOCK
    qb = q.reshape(b, h, nb, ATT_BLOCK, d).transpose(2, 0, 1, 3, 4)
    scale = d ** -0.5

    def attend(qblk):
        s = jnp.einsum('bhqd,bhkd->bhqk', qblk, k).astype(F32) * scale
        p = jax.nn.softmax(s, axis=-1).astype(v.dtype)
        return jnp.einsum('bhqk,bhkd->bhqd', p, v)

    o = lax.map(attend, qb)
    return o.transpose(1, 2, 0, 3, 4).reshape(b, h, lq, v.shape[-1])


def s5_discretize(a_re, a_im, log_dt, b_re, b_im):
    dt = jnp.exp(log_dt)[:, None]
    mag = jnp.exp(a_re * dt)
    ab_re = mag * jnp.cos(a_im * dt)
    ab_im = mag * jnp.sin(a_im * dt)
    nr, ni = ab_re - 1.0, ab_im
    den = a_re * a_re + a_im * a_im
    fr = (nr * a_re + ni * a_im) / den
    fi = (ni * a_re - nr * a_im) / den
    bb_re = fr[..., None] * b_re - fi[..., None] * b_im
    bb_im = fr[..., None] * b_im + fi[..., None] * b_re
    return ab_re, ab_im, bb_re, bb_im


def _complex_affine_combine(e1, e2):
    a1r, a1i, b1r, b1i = e1
    a2r, a2i, b2r, b2i = e2
    return (a2r * a1r - a2i * a1i, a2r * a1i + a2i * a1r,
            a2r * b1r - a2i * b1i + b2r, a2r * b1i + a2i * b1r + b2i)


def s5_direction(u, s0, ab_re, ab_im, bb_re, bb_im, c_re, c_im):
    bu_re = jnp.einsum('gpk,blgk->blgp', bb_re, u)
    bu_im = jnp.einsum('gpk,blgk->blgp', bb_im, u)
    h0r, h0i = s0
    bu_re = bu_re.at[:, 0].add(ab_re * h0r - ab_im * h0i)
    bu_im = bu_im.at[:, 0].add(ab_re * h0i + ab_im * h0r)
    ar = jnp.broadcast_to(ab_re.astype(bu_re.dtype), bu_re.shape)
    ai = jnp.broadcast_to(ab_im.astype(bu_re.dtype), bu_re.shape)
    _, _, hr, hi = lax.associative_scan(_complex_affine_combine, (ar, ai, bu_re, bu_im), axis=1)
    y = jnp.einsum('gkp,blgp->blgk', c_re, hr) - jnp.einsum('gkp,blgp->blgk', c_im, hi)
    return y, (hr[:, -1], hi[:, -1])


def s5_mixer(ux, uc, a_re, a_im, log_dt, b_re, b_im, c_re, c_im, d, w_glu, ctx_out):
    b, lx, _ = ux.shape
    lc = uc.shape[1]
    gx = ux.reshape(b, lx, S5_GROUPS, S5_GROUP)
    gc = uc.reshape(b, lc, S5_GROUPS, S5_GROUP)
    zero = jnp.zeros((b, S5_GROUPS, S5_STATE), ux.dtype)
    yx = d * ux
    yc = d * uc
    for r in range(2):
        ab_re, ab_im, bb_re, bb_im = s5_discretize(a_re[r], a_im[r], log_dt[r], b_re[r], b_im[r])
        fn = functools.partial(s5_direction, ab_re=ab_re, ab_im=ab_im, bb_re=bb_re, bb_im=bb_im,
                               c_re=c_re[r], c_im=c_im[r])
        ox, oc = context_then_latent(fn, (gc,), (gx,), (zero, zero), 1, r == 1)
        yx = yx + ox.reshape(b, lx, S5_WIDTH)
        yc = yc + oc.reshape(b, lc, S5_WIDTH)

    def glu(y):
        z = jax.nn.gelu(y)
        return z * jax.nn.sigmoid(z @ w_glu)

    return glu(yx), (glu(yc) if ctx_out else None)


def mla_queries(cq, q_norm, w_uq, rope):
    b, l, _ = cq.shape
    q = (rms_norm(cq, q_norm) @ w_uq).reshape(b, l, MLA_HEADS, MLA_NOPE + MLA_ROPE).transpose(0, 2, 1, 3)
    if rope is not None:
        q = jnp.concatenate([q[..., :MLA_NOPE], apply_rope(q[..., MLA_NOPE:], *rope)], axis=-1)
    return q


def mla_keys_values(ckv, kr, kv_norm, w_ukv, rope):
    b, l, _ = ckv.shape
    kv = (rms_norm(ckv, kv_norm) @ w_ukv).reshape(b, l, MLA_HEADS, MLA_NOPE + MLA_V).transpose(0, 2, 1, 3)
    kr = kr[:, None]
    if rope is not None:
        kr = apply_rope(kr, *rope)
    k = jnp.concatenate([kv[..., :MLA_NOPE], jnp.broadcast_to(kr, (b, MLA_HEADS, l, MLA_ROPE))], axis=-1)
    return k, kv[..., MLA_NOPE:]


def even_mixer(hx, hc, w_in, a_re, a_im, log_dt, b_re, b_im, c_re, c_im, d, w_glu,
               q_norm, w_uq, kv_norm, w_ukv, rope, ctx_out):
    ux, cqx, ckvx, krx = split_cols(hx @ w_in, EVEN_SIZES)
    uc, cqc, ckvc, krc = split_cols(hc @ w_in, EVEN_SIZES)
    yx, yc = s5_mixer(ux, uc, a_re, a_im, log_dt, b_re, b_im, c_re, c_im, d, w_glu, ctx_out)
    kx, vx = mla_keys_values(ckvx, krx, kv_norm, w_ukv, rope)
    kc, vc = mla_keys_values(ckvc, krc, kv_norm, w_ukv, None)
    qx = mla_queries(cqx, q_norm, w_uq, rope)
    ox = block_attention(qx, jnp.concatenate([kc, kx], axis=2), jnp.concatenate([vc, vx], axis=2))
    out_x = jnp.concatenate([yx, merge_heads(ox)], axis=-1)
    if not ctx_out:
        return out_x, None
    oc = block_attention(mla_queries(cqc, q_norm, w_uq, None), kc, vc)
    return out_x, jnp.concatenate([yc, merge_heads(oc)], axis=-1)


def retention_direction(q, k, v, s0, log_gamma):
    b, h, l, dk = q.shape
    dv = v.shape[-1]
    c = RET_CHUNK
    n = l // c
    dt = q.dtype
    pos = jnp.arange(c, dtype=F32)
    lg = log_gamma[:, None]
    rel = pos[:, None] - pos[None, :]
    dmask = jnp.where(rel >= 0, jnp.exp(lg[:, :, None] * jnp.maximum(rel, 0.0)), 0.0).astype(dt)
    k_w = jnp.exp(lg * (c - 1 - pos)).astype(dt)
    q_w = jnp.exp(lg * (pos + 1)).astype(dt)
    g_c = jnp.exp(log_gamma * c).astype(dt)[None, :, None, None]
    qc = q.reshape(b, h, n, c, dk)
    kc = k.reshape(b, h, n, c, dk)
    vc = v.reshape(b, h, n, c, dv)
    inner = jnp.einsum('bhntd,bhnsd->bhnts', qc, kc) * dmask[:, None]
    o_intra = jnp.einsum('bhnts,bhnse->bhnte', inner, vc)
    chunk_kv = jnp.einsum('bhnsd,hs,bhnse->nbhde', kc, k_w, vc)

    def step(s, kv):
        return (g_c * s + kv).astype(s.dtype), s

    s_fin, s_prev = lax.scan(step, s0, chunk_kv)
    o_cross = jnp.einsum('bhntd,ht,nbhde->bhnte', qc, q_w, s_prev)
    return (o_intra + o_cross).reshape(b, h, l, dv), s_fin


def retention_mixer(parts_x, parts_c, gn, rope, ctx_out):
    q_x, k_x, v_x, g_x = parts_x
    q_c, k_c, v_c, g_c = parts_c
    scale = RET_DK ** -0.5
    qxh = apply_rope(split_heads(q_x, RET_HEADS), *rope)
    kxh = apply_rope(split_heads(k_x, RET_HEADS), *rope) * scale
    vxh = split_heads(v_x, RET_HEADS)
    qch = split_heads(q_c, RET_HEADS)
    kch = split_heads(k_c, RET_HEADS) * scale
    vch = split_heads(v_c, RET_HEADS)
    s0 = jnp.zeros((q_x.shape[0], RET_HEADS, RET_DK, RET_DV), q_x.dtype)
    ox = jnp.zeros_like(vxh)
    oc = jnp.zeros_like(vch)
    for r, offset in enumerate(RET_DECAY_OFFSETS):
        log_gamma = jnp.log1p(-jnp.exp2(-(5.0 + offset) - jnp.arange(RET_HEADS, dtype=F32)))
        fn = functools.partial(retention_direction, log_gamma=log_gamma)
        o_x, o_c = context_then_latent(fn, (qch, kch, vch), (qxh, kxh, vxh), s0, 2, r == 1)
        ox = ox + o_x
        oc = oc + o_c
    out_x = head_norm(ox, gn, True) * jax.nn.silu(g_x)
    return out_x, (head_norm(oc, gn, True) * jax.nn.silu(g_c) if ctx_out else None)


def hgrn2_direction(q, k, v, logf, s0):
    b, h, l, dk = q.shape
    dv = v.shape[-1]
    n = l // HG_CHUNK
    causal = jnp.tril(jnp.ones((HG_CHUNK, HG_CHUNK), bool))[:, :, None]

    def chunks(t):
        return t.reshape(b, h, n, HG_CHUNK, t.shape[-1]).transpose(2, 0, 1, 3, 4)

    def step(s, blk):
        qb, kb, vb, lf = blk
        cum = jnp.cumsum(lf.astype(F32), axis=2)
        pair = jnp.where(causal, jnp.exp(jnp.minimum(cum[:, :, :, None] - cum[:, :, None], 0.0)), 0.0)
        att = jnp.einsum('bhtd,bhsd,bhtsd->bhts', qb, kb, pair.astype(qb.dtype))
        o = att @ vb + jnp.einsum('bhtd,bhde->bhte', qb * jnp.exp(cum).astype(qb.dtype), s)
        end = cum[:, :, -1:]
        s_new = (jnp.exp(end[:, :, 0])[..., None].astype(s.dtype) * s
                 + jnp.einsum('bhsd,bhse->bhde', kb * jnp.exp(end - cum).astype(kb.dtype), vb))
        return s_new.astype(s.dtype), o

    s_fin, o = lax.scan(step, s0, (chunks(q), chunks(k), chunks(v), chunks(logf)))
    return o.transpose(1, 2, 0, 3, 4).reshape(b, h, l, dv), s_fin


def hgrn2_mixer(parts_x, parts_c, lb, gn, ctx_out):
    lbh = lb.reshape(HG_HEADS, 1, HG_DK)

    def prep(q, ff, fb, i):
        gates = []
        for fpre in (ff, fb):
            f = lbh + (1.0 - lbh) * jax.nn.sigmoid(split_heads(fpre, HG_HEADS).astype(F32))
            gates.append(((1.0 - f).astype(q.dtype), jnp.log(f).astype(q.dtype)))
        return split_heads(q, HG_HEADS), split_heads(i, HG_HEADS), gates

    q_x, ff_x, fb_x, i_x, g_x = parts_x
    q_c, ff_c, fb_c, i_c, g_c = parts_c
    qxh, ixh, gates_x = prep(q_x, ff_x, fb_x, i_x)
    qch, ich, gates_c = prep(q_c, ff_c, fb_c, i_c)
    s0 = jnp.zeros((q_x.shape[0], HG_HEADS, HG_DK, HG_DV), q_x.dtype)
    ox = jnp.zeros_like(ixh)
    oc = jnp.zeros_like(ich)
    for r in range(2):
        o_x, o_c = context_then_latent(hgrn2_direction,
                                       (qch, gates_c[r][0], ich, gates_c[r][1]),
                                       (qxh, gates_x[r][0], ixh, gates_x[r][1]), s0, 2, r == 1)
        ox = ox + o_x
        oc = oc + o_c
    out_x = head_norm(ox, gn, False) * jax.nn.silu(g_x)
    return out_x, (head_norm(oc, gn, False) * jax.nn.silu(g_c) if ctx_out else None)


def odd_mixer(hx, hc, w_in, ret_gn, lb, hg_gn, rope, ctx_out):
    px = split_cols(hx @ w_in, ODD_SIZES)
    pc = split_cols(hc @ w_in, ODD_SIZES)
    rx, rc = retention_mixer(px[:4], pc[:4], ret_gn, rope, ctx_out)
    gx, gc = hgrn2_mixer(px[4:], pc[4:], lb, hg_gn, ctx_out)
    out_x = jnp.concatenate([rx, gx], axis=-1)
    return out_x, (jnp.concatenate([rc, gc], axis=-1) if ctx_out else None)


def setup_inputs(seed: int = 0) -> dict:
    key = jax.random.key(seed)
    ks = iter(jax.random.split(key, 48))

    def nrm(shape, scale):
        return jax.random.normal(next(ks), shape, F32) * scale

    D = D_MODEL
    G, P, K = S5_GROUPS, S5_STATE, S5_GROUP
    return {
        'x': nrm((BATCH, SEQ, D), 1.0),
        'c': nrm((BATCH, D), 1.0),
        'ctx': nrm((BATCH, CTX_LEN, D), 1.0),
        'c_ctx': nrm((D,), 1.0),
        'w_mod': nrm((DEPTH, D, 6 * D), 0.5 * D ** -0.5),
        'b_mod': nrm((DEPTH, 6 * D), 0.01),
        'norm1_g': 1.0 + nrm((DEPTH, D), 0.01),
        'norm2_g': 1.0 + nrm((DEPTH, D), 0.01),
        'ffn_w1': nrm((DEPTH, D, D_FF), D ** -0.5),
        'ffn_w3': nrm((DEPTH, D, D_FF), D ** -0.5),
        'ffn_w2': nrm((DEPTH, D_FF, D), D_FF ** -0.5),
        'w_in_even': nrm((N_EVEN, D, EVEN_IN), D ** -0.5),
        'w_out_even': nrm((N_EVEN, EVEN_MIX, D), EVEN_MIX ** -0.5),
        's5_a_re': -0.5 + nrm((N_EVEN, 2, G, P), 0.01),
        's5_a_im': math.pi * jnp.arange(P, dtype=F32) + nrm((N_EVEN, 2, G, P), 0.01),
        's5_log_dt': jax.random.uniform(next(ks), (N_EVEN, 2, G), F32, math.log(1e-3), math.log(1e-1)),
        's5_b_re': nrm((N_EVEN, 2, G, P, K), (2 * K) ** -0.5),
        's5_b_im': nrm((N_EVEN, 2, G, P, K), (2 * K) ** -0.5),
        's5_c_re': nrm((N_EVEN, 2, G, K, P), (2 * P) ** -0.5),
        's5_c_im': nrm((N_EVEN, 2, G, K, P), (2 * P) ** -0.5),
        's5_d': nrm((N_EVEN, S5_WIDTH), 1.0),
        's5_w_glu': nrm((N_EVEN, S5_WIDTH, S5_WIDTH), S5_WIDTH ** -0.5),
        'mla_q_norm': 1.0 + nrm((N_EVEN, MLA_Q_RANK), 0.01),
        'mla_w_uq': nrm((N_EVEN, MLA_Q_RANK, MLA_HEADS * (MLA_NOPE + MLA_ROPE)), MLA_Q_RANK ** -0.5),
        'mla_kv_norm': 1.0 + nrm((N_EVEN, MLA_KV_RANK), 0.01),
        'mla_w_ukv': nrm((N_EVEN, MLA_KV_RANK, MLA_HEADS * (MLA_NOPE + MLA_V)), MLA_KV_RANK ** -0.5),
        'w_in_odd': nrm((N_ODD, D, ODD_IN), D ** -0.5),
        'w_out_odd': nrm((N_ODD, ODD_MIX, D), ODD_MIX ** -0.5),
        'ret_gn': 1.0 + nrm((N_ODD, RET_VW), 0.01),
        'hg_lb_logits': nrm((N_ODD + 1, HG_QK), 0.1),
        'hg_gn': 1.0 + nrm((N_ODD, HG_VW), 0.01),
        'final_norm': 1.0 + nrm((D,), 0.01),
    }


def reference(x, c, ctx, c_ctx, w_mod, b_mod, norm1_g, norm2_g, ffn_w1, ffn_w3, ffn_w2,
              w_in_even, w_out_even, s5_a_re, s5_a_im, s5_log_dt, s5_b_re, s5_b_im, s5_c_re, s5_c_im,
              s5_d, s5_w_glu, mla_q_norm, mla_w_uq, mla_kv_norm, mla_w_ukv,
              w_in_odd, w_out_odd, ret_gn, hg_lb_logits, hg_gn, final_norm):
    b, l, _ = x.shape
    rows = l // GRID_W
    rope_mla = axial_rope(rows, MLA_ROPE)
    rope_ret = axial_rope(rows, RET_DK)
    hg_lb = jnp.cumsum(jax.nn.softmax(hg_lb_logits.astype(F32), axis=0), axis=0)[:N_ODD]
    for li in range(DEPTH):
        last = li == DEPTH - 1
        mx = (jax.nn.silu(c) @ w_mod[li] + b_mod[li])[:, None, :]
        mc = (jax.nn.silu(c_ctx) @ w_mod[li] + b_mod[li])[None, None, :]
        sx1, ax1, gx1, sx2, ax2, gx2 = jnp.split(mx, 6, axis=-1)
        sc1, ac1, gc1, sc2, ac2, gc2 = jnp.split(mc, 6, axis=-1)
        hx = rms_norm(x, norm1_g[li]) * (1.0 + ax1) + sx1
        hc = rms_norm(ctx, norm1_g[li]) * (1.0 + ac1) + sc1
        j = li // 2
        if li % 2 == 0:
            mix_x, mix_c = even_mixer(hx, hc, w_in_even[j], s5_a_re[j], s5_a_im[j], s5_log_dt[j],
                                      s5_b_re[j], s5_b_im[j], s5_c_re[j], s5_c_im[j], s5_d[j], s5_w_glu[j],
                                      mla_q_norm[j], mla_w_uq[j], mla_kv_norm[j], mla_w_ukv[j],
                                      rope_mla, not last)
            w_out = w_out_even[j]
        else:
            mix_x, mix_c = odd_mixer(hx, hc, w_in_odd[j], ret_gn[j], hg_lb[j], hg_gn[j], rope_ret, not last)
            w_out = w_out_odd[j]
        x = x + gx1 * (mix_x @ w_out)
        x = x + gx2 * swiglu(rms_norm(x, norm2_g[li]) * (1.0 + ax2) + sx2, ffn_w1[li], ffn_w3[li], ffn_w2[li])
        if not last:
            ctx = ctx + gc1 * (mix_c @ w_out)
            ctx = ctx + gc2 * swiglu(rms_norm(ctx, norm2_g[li]) * (1.0 + ac2) + sc2,
                                     ffn_w1[li], ffn_w3[li], ffn_w2[li])
    return rms_norm(x, final_norm)
```

```cpp
#include <hip/hip_runtime.h>
#include <hip/hip_cooperative_groups.h>
#include <cstdio>
namespace cg = cooperative_groups;
#ifndef PROBE
#define PROBE 0
#endif
#define REP(mask) ((PROBE & (mask)) ? 2 : 1)
#define DI __device__ __forceinline__
#define LAS __attribute__((address_space(3)))
typedef unsigned short u16;
typedef short bf16x8 __attribute__((ext_vector_type(8)));
typedef float f32x4 __attribute__((ext_vector_type(4)));
typedef float f32x16 __attribute__((ext_vector_type(16)));
typedef unsigned u32x4 __attribute__((ext_vector_type(4)));
typedef unsigned u32x2 __attribute__((ext_vector_type(2)));

constexpr int DM = 1024, SEQ = 8192, CTXL = 256, NLAT = 16384, NCTX = 512, NTOK = 16896, DFF = 2816, LK = 8448;
constexpr int NCH = 132;
constexpr float EPS = 1e-6f;

constexpr size_t al256(size_t x) { return (x + 255) & ~(size_t)255; }
constexpr size_t OFF_MOD = 0;
constexpr size_t OFF_RMLA = al256(OFF_MOD + 4 * 3 * 6144 * 4);
constexpr size_t OFF_RRET = al256(OFF_RMLA + 8192 * 16 * 2 * 4);
constexpr size_t OFF_LB = al256(OFF_RRET + 8192 * 64 * 2 * 4);
constexpr size_t OFF_SAB = al256(OFF_LB + 2 * 512 * 4);
constexpr size_t OFF_SA64 = al256(OFF_SAB + 2 * 2 * 2048 * 8);
constexpr size_t OFF_SBB = al256(OFF_SA64 + 2 * 2 * 2048 * 8);
constexpr size_t OFF_SCC = al256(OFF_SBB + 2 * 2 * 2048 * 16 * 8);
constexpr size_t OFF_SSQ = al256(OFF_SCC + 2 * 2 * 32 * 16 * 128 * 2);
constexpr size_t OFF_GDEC = al256(OFF_SSQ + (size_t)NTOK * 12 * 4);
constexpr size_t OFF_WMIX = al256(OFF_GDEC + 2 * 4 * 2 * NCH * 128 * 4);
constexpr size_t WMIX_BYTES = 9437184 + 2097152;
constexpr size_t OFF_WFFN = al256(OFF_WMIX + WMIX_BYTES);
constexpr size_t WFFN_BYTES = (size_t)5632 * 1024 * 2 + (size_t)1024 * 2816 * 2;
constexpr size_t OFF_XRES = al256(OFF_WFFN + WFFN_BYTES);
constexpr size_t OFF_HB = al256(OFF_XRES + (size_t)NTOK * 1024 * 4);
constexpr size_t OFF_BIG = al256(OFF_HB + (size_t)NTOK * 1024 * 2);
constexpr size_t BE_U = 0;
constexpr size_t BE_CQKV = al256(BE_U + (size_t)NTOK * 512 * 2);
constexpr size_t BE_Q = al256(BE_CQKV + (size_t)NTOK * 384 * 2);
constexpr size_t BE_KC = al256(BE_Q + (size_t)NTOK * 768 * 2);
constexpr size_t BE_VT = al256(BE_KC + (size_t)2 * 8 * LK * 96 * 2);
constexpr size_t BE_Z = al256(BE_VT + (size_t)2 * 8 * 64 * LK * 2);
constexpr size_t BE_S5E = al256(BE_Z + (size_t)NTOK * 512 * 2);
constexpr size_t BO_PROJ = 0;
constexpr size_t BO_GST = al256(BO_PROJ + (size_t)NTOK * 4608 * 2);
constexpr size_t BIG_BYTES = BO_GST + (size_t)2 * 4 * 2 * NCH * 16384 * 2;
constexpr size_t OFF_BAR = al256(OFF_BIG + BIG_BYTES);
constexpr size_t OFF_MODP = OFF_BAR + 16384;
constexpr size_t WS_NEED = OFF_MODP + (size_t)16 * 4 * 3 * 6144 * 4;
constexpr size_t WE_IN = 0, WE_OUT = 2097152, WE_GLU = 4194304, WE_UQ = 4718592, WE_UKV = 5242880;
constexpr size_t WO_IN = 0, WO_OUT = 9437184;
constexpr size_t WF_13 = 0, WF_2 = (size_t)5632 * 1024 * 2;

struct Params { const float* in[32]; float* out; unsigned char* ws; };

DI int tidx() { int t = threadIdx.x; asm volatile("" : "+v"(t)); return t; }
typedef float f32x2 __attribute__((ext_vector_type(2)));
typedef __bf16 bf16x2_t __attribute__((ext_vector_type(2)));
DI unsigned pk2(float lo, float hi) { const f32x2 v = {lo, hi}; const bf16x2_t b = __builtin_convertvector(v, bf16x2_t); return __builtin_bit_cast(unsigned, b); }
DI u16 f2bf(float x) { return (u16)(pk2(x, x) & 0xffffu); }
DI float bf2f(u16 b) { return __uint_as_float(((unsigned)b) << 16); }
DI float bflo(unsigned w) { return __uint_as_float(w << 16); }
DI float bfhi(unsigned w) { return __uint_as_float(w & 0xffff0000u); }
DI float sigmoidf_(float x) { return 1.f / (1.f + __expf(-x)); }
DI float siluf_(float x) { return x / (1.f + __expf(-x)); }
DI float gelu_tanh(float y) { float t = 0.7978845608028654f * (y + 0.044715f * y * y * y); return 0.5f * y * (1.f + tanhf(t)); }
DI int tok_b(int row) { return row < NLAT ? (row >> 13) : ((row - NLAT) >> 8); }
DI int tok_bidx(int row) { return row < NLAT ? (row >> 13) : 2; }
#define MFMA32(a, b, c) __builtin_amdgcn_mfma_f32_32x32x16_bf16((a), (b), (c), 0, 0, 0)
#define MFMA16(a, b, c) __builtin_amdgcn_mfma_f32_16x16x32_bf16((a), (b), (c), 0, 0, 0)
DI int scan_idx(int jc, int dir) { return dir ? (jc < 4 ? 3 - jc : 135 - jc) : jc; }
DI int crow32(int i, int hh) { return (i & 3) + 8 * (i >> 2) + 4 * hh; }

namespace pg8 {
constexpr int BM = 256, BK = 64, HALF = 128, HTB = HALF * BK * 2, NXCD = 8, WGM = 8;
DI int lds_byte(int r, int c) { const int st = (r >> 4) * 2 + (c >> 5), rr = r & 15, cc = c & 31, ob = rr * 64 + cc * 2; return st * 1024 + (ob ^ (((ob >> 9) & 1) << 5)); }
DI void stage_rc(int b, int& R, int& C) { const int st = b / 1024, sb = b % 1024, swz = sb ^ (((sb >> 9) & 1) << 5); R = (st >> 1) * 16 + swz / 64; C = (st & 1) * 32 + (swz % 64) / 2; }
struct Unit { int pm, pn, ks; };
struct Gemm { const u16* A; const u16* Bt; int M, N, K, lda, ldb; };
struct StaticOrder {
    int nM, nN, nwg, G, c;
    DI void init(int M, int N, int G_, int c_) { nM = M / BM; nN = N / BM; nwg = nM * nN; G = G_; c = c_; }
    DI bool next(int i, Unit& u) const {
        const long L = (long)i * G + c; if (L >= nwg) return false;
        int wgid = (int)L; { const int q = nwg / NXCD, r = nwg % NXCD, xcd = wgid % NXCD, off = wgid / NXCD; wgid = (xcd < r ? xcd * (q + 1) : r * (q + 1) + (xcd - r) * q) + off; }
        const int nig = WGM * nN, gid = wgid / nig, fm = gid * WGM, gsz = (nM - fm) < WGM ? (nM - fm) : WGM;
        u.pm = fm + ((wgid % nig) % gsz); u.pn = (wgid % nig) / gsz; u.ks = -1; return true;
    }
};
struct MixedOrder {
    StaticOrder lat; int nN, KS, nlat, ntot;
    DI void init(int N, int KS_, int G_, int c_) { lat.init(16384, N, G_, c_); nN = N / BM; KS = KS_; nlat = lat.nwg; ntot = nlat + 2 * nN * KS; }
    DI bool next(int i, Unit& u) const {
        const long L = (long)i * lat.G + lat.c; if (L >= ntot) return false;
        if (L < nlat) return lat.next(i, u);
        const int e = (int)L - nlat, r = e / KS; u.ks = e - r * KS; u.pn = r % nN; u.pm = 64 + r / nN; return true;
    }
};
template <class Epi, class Sched>
DI void gemm_phase(LAS unsigned char* lds, const Gemm g, const Sched& S, const Epi& E) {
    const int tid = tidx(), wid = __builtin_amdgcn_readfirstlane(tid >> 6), lane = tid & 63, wr = wid >> 2, wc = wid & 3, fr = lane & 15, fq = lane >> 4;
    int K = g.K; asm volatile("" : "+s"(K)); const int ntFull = K / BK;
    unsigned voffA[2], voffB[2];
#pragma unroll
    for (int i = 0; i < 2; ++i) { int R, C; stage_rc(tid * 16 + i * 8192, R, C);
        voffA[i] = (unsigned)(R * g.lda + C) * 2u; voffB[i] = (unsigned)(R * g.ldb + C) * 2u; }
    const size_t kstep = (size_t)(BK * 2);
    const size_t hstepA = (size_t)HALF * g.lda * 2, hstepB = (size_t)HALF * g.ldb * 2;
    const size_t tstepA = 2 * hstepA, tstepB = 2 * hstepB;
    const unsigned ldsw = (unsigned)wid * 1024u;
    const int aoff = lds_byte(wr * 64 + fr, fq * 8), boff = lds_byte(wc * 32 + fr, fq * 8);
#define PG8_SA(b, h) (((b) * 2 + (h)) * HTB)
#define PG8_SB(b, h) ((4 + (b) * 2 + (h)) * HTB)
#define PG8_STAGE(bufoff, gbase, voff) do { _Pragma("unroll") for (int _i = 0; _i < 2; ++_i) \
        __builtin_amdgcn_global_load_lds((const unsigned*)((const char*)(gbase) + (voff)[_i]), (LAS unsigned*)(lds + (bufoff) + ldsw + _i * 8192), 16, 0, 0); } while (0)
#define PG8_LDA(dst, b, h) do { _Pragma("unroll") for (int m = 0; m < 4; ++m) _Pragma("unroll") for (int k = 0; k < 2; ++k) dst[m][k] = *(const LAS bf16x8*)(lds + PG8_SA(b, h) + aoff + m * 2048 + k * 1024); } while (0)
#define PG8_LDB(dst, b, h) do { _Pragma("unroll") for (int n = 0; n < 2; ++n) _Pragma("unroll") for (int k = 0; k < 2; ++k) dst[n][k] = *(const LAS bf16x8*)(lds + PG8_SB(b, h) + boff + n * 2048 + k * 1024); } while (0)
#define PG8_MMA(ai, bj, At, Bt) do { __builtin_amdgcn_s_setprio(1); _Pragma("unroll") for (int m = 0; m < 4; ++m) _Pragma("unroll") for (int n = 0; n < 2; ++n) _Pragma("unroll") for (int k = 0; k < 2; ++k) \
        acc[ai][bj][m][n] = __builtin_amdgcn_mfma_f32_16x16x32_bf16(Bt[n][k], At[m][k], acc[ai][bj][m][n], 0, 0, 0); __builtin_amdgcn_s_setprio(0); } while (0)
#define PG8_WAIT_V(n) asm volatile("s_waitcnt vmcnt(" #n ")" ::: "memory")
#define PG8_WAIT_L(n) asm volatile("s_waitcnt lgkmcnt(" #n ")" ::: "memory")
#define PG8_BAR __builtin_amdgcn_s_barrier()
#define PG8_SCHED __builtin_amdgcn_sched_barrier(0)
    Unit cur, nxt; int ui = 0;
    if (!S.next(0, cur)) return;
    f32x4 acc[2][2][4][2];
#pragma unroll
    for (int a = 0; a < 2; ++a)
#pragma unroll
        for (int b = 0; b < 2; ++b)
#pragma unroll
            for (int m = 0; m < 4; ++m)
#pragma unroll
                for (int n = 0; n < 2; ++n) acc[a][b][m][n] = (f32x4){0.f, 0.f, 0.f, 0.f};
    bf16x8 At[4][2], B0[2][2], B1[2][2];
    const char* cA = (const char*)g.A + (size_t)cur.pm * tstepA + (cur.ks >= 0 ? cur.ks * 512 : 0); const char* cB = (const char*)g.Bt + (size_t)cur.pn * tstepB + (cur.ks >= 0 ? cur.ks * 512 : 0);
    int nt = cur.ks >= 0 ? 4 : ntFull;
    PG8_STAGE(PG8_SB(0, 0), cB, voffB); PG8_STAGE(PG8_SA(0, 0), cA, voffA); PG8_STAGE(PG8_SB(0, 1), cB + hstepB, voffB); PG8_STAGE(PG8_SA(0, 1), cA + hstepA, voffA);
    if (wr == 1) PG8_BAR;
    PG8_WAIT_V(4); PG8_BAR;
    PG8_STAGE(PG8_SB(1, 0), cB + kstep, voffB); PG8_STAGE(PG8_SA(1, 0), cA + kstep, voffA); PG8_STAGE(PG8_SB(1, 1), cB + hstepB + kstep, voffB);
    PG8_WAIT_V(6); PG8_BAR;
    for (;;) {
        const bool has_next = S.next(ui + 1, nxt);
        const char* nA = has_next ? (const char*)g.A + (size_t)nxt.pm * tstepA + (nxt.ks >= 0 ? nxt.ks * 512 : 0) : cA; const char* nB = has_next ? (const char*)g.Bt + (size_t)nxt.pn * tstepB + (nxt.ks >= 0 ? nxt.ks * 512 : 0) : cB;
        for (int t = 0; t < nt; t += 2) {
            const bool last = (t == nt - 2);
            const char* a1 = cA + (size_t)(t + 1) * kstep;
            const char* a2 = last ? nA : cA + (size_t)(t + 2) * kstep; const char* b2 = last ? nB : cB + (size_t)(t + 2) * kstep;
            const char* a3 = a2 + kstep; const char* b3 = b2 + kstep;
            PG8_LDB(B0, 0, 0); PG8_SCHED; PG8_LDA(At, 0, 0); PG8_STAGE(PG8_SA(1, 1), a1 + hstepA, voffA);
            PG8_WAIT_L(8); PG8_BAR; PG8_WAIT_L(0); PG8_MMA(0, 0, At, B0); PG8_BAR; PG8_SCHED;
            PG8_LDB(B1, 0, 1); PG8_STAGE(PG8_SB(0, 0), b2, voffB);
            PG8_BAR; PG8_WAIT_L(0); PG8_MMA(0, 1, At, B1); PG8_BAR;
            PG8_LDA(At, 0, 1); PG8_STAGE(PG8_SA(0, 0), a2, voffA);
            PG8_BAR; PG8_WAIT_L(0); PG8_MMA(1, 0, At, B0); PG8_BAR; PG8_SCHED;
            PG8_STAGE(PG8_SB(0, 1), b2 + hstepB, voffB);
            PG8_WAIT_V(6); PG8_BAR; PG8_MMA(1, 1, At, B1); PG8_BAR;
            PG8_LDB(B0, 1, 0); PG8_SCHED; PG8_LDA(At, 1, 0); PG8_STAGE(PG8_SA(0, 1), a2 + hstepA, voffA);
            PG8_WAIT_L(8); PG8_BAR; PG8_WAIT_L(0); PG8_MMA(0, 0, At, B0); PG8_BAR; PG8_SCHED;
            PG8_LDB(B1, 1, 1); PG8_STAGE(PG8_SB(1, 0), b3, voffB);
            PG8_BAR; PG8_WAIT_L(0); PG8_MMA(0, 1, At, B1); PG8_BAR;
            PG8_LDA(At, 1, 1); PG8_STAGE(PG8_SA(1, 0), a3, voffA);
            PG8_BAR; PG8_WAIT_L(0); PG8_MMA(1, 0, At, B0); PG8_BAR; PG8_SCHED;
            PG8_STAGE(PG8_SB(1, 1), b3 + hstepB, voffB);
            PG8_WAIT_V(6); PG8_BAR; PG8_MMA(1, 1, At, B1); PG8_BAR;
        }
        { int fr2 = fr, fq2 = fq; asm volatile("" : "+v"(fr2), "+v"(fq2)); E(acc, cur, wr, wc, fr2, fq2); }
        if (!has_next) break;
#pragma unroll
        for (int a = 0; a < 2; ++a)
#pragma unroll
            for (int b = 0; b < 2; ++b)
#pragma unroll
                for (int m = 0; m < 4; ++m)
#pragma unroll
                    for (int n = 0; n < 2; ++n) acc[a][b][m][n] = (f32x4){0.f, 0.f, 0.f, 0.f};
        cur = nxt; cA = nA; cB = nB; ++ui; nt = cur.ks >= 0 ? 4 : ntFull;
    }
    PG8_WAIT_V(0);
    if (wr == 0) PG8_BAR;
    PG8_BAR;
#undef PG8_SA
#undef PG8_SB
#undef PG8_STAGE
#undef PG8_LDA
#undef PG8_LDB
#undef PG8_MMA
#undef PG8_WAIT_V
#undef PG8_WAIT_L
#undef PG8_BAR
#undef PG8_SCHED
}
}
using pg8::Unit;
typedef f32x4 AccT[2][2][4][2];
#define EPI_ROW(u, ai, m) ((u).pm * 256 + (ai) * 128 + wr * 64 + (m) * 16 + fr)
#define EPI_COLBASE(u, bj) ((u).pn * 256 + (bj) * 128 + wc * 32)

template <class Epi>
DI void run_gemm(LAS unsigned char* lds, const u16* A, int lda, const u16* Bt, int ldb, int M, int N, int K, const Epi& E) {
    pg8::Gemm g; g.A = A; g.Bt = Bt; g.M = M; g.N = N; g.K = K; g.lda = lda; g.ldb = ldb;
    pg8::StaticOrder S; S.init(M, N, (int)gridDim.x, (int)blockIdx.x);
    pg8::gemm_phase<Epi, pg8::StaticOrder>(lds, g, S, E);
    __syncthreads();
}
template <class Epi>
DI void run_gemm_mixed(LAS unsigned char* lds, const u16* A, int lda, const u16* Bt, int ldb, int N, int K, const Epi& E) {
    pg8::Gemm g; g.A = A; g.Bt = Bt; g.M = NTOK; g.N = N; g.K = K; g.lda = lda; g.ldb = ldb;
    pg8::MixedOrder S; S.init(N, K / 256, (int)gridDim.x, (int)blockIdx.x);
    pg8::gemm_phase<Epi, pg8::MixedOrder>(lds, g, S, E);
    __syncthreads();
}

DI void rope4(f32x4& v, const float* cs  ) {
    const f32x4 t = *(const f32x4*)cs;
    const float a0 = v[0] * t[0] - v[1] * t[1], a1 = v[0] * t[1] + v[1] * t[0];
    const float b0 = v[2] * t[2] - v[3] * t[3], b1 = v[2] * t[3] + v[3] * t[2];
    v = (f32x4){a0, a1, b0, b1};
}
DI u32x2 pack4(const f32x4& v) { u32x2 r; r.x = pk2(v[0], v[1]); r.y = pk2(v[2], v[3]); return r; }

struct EpiInEven {
    u16* U; u16* CQKV; u16* KC; float* ssq; float* sskv; const float* rope;
    DI void operator()(const AccT& acc, const Unit& u, int wr, int wc, int fr, int fq) const {
#pragma unroll
        for (int ai = 0; ai < 2; ++ai)
#pragma unroll
            for (int m = 0; m < 4; ++m) {
                const int row = EPI_ROW(u, ai, m);
#pragma unroll
                for (int bj = 0; bj < 2; ++bj) {
                    const int cb = EPI_COLBASE(u, bj);
                    if (cb < 512) {
#pragma unroll
                        for (int n = 0; n < 2; ++n) *(u32x2*)(U + (size_t)row * 512 + cb + n * 16 + 4 * fq) = pack4(acc[ai][bj][m][n]);
                    } else if (cb < 896) {
                        float ss = 0.f;
#pragma unroll
                        for (int n = 0; n < 2; ++n) { const f32x4 v = acc[ai][bj][m][n];
                            *(u32x2*)(CQKV + (size_t)row * 384 + (cb - 512) + n * 16 + 4 * fq) = pack4(v);
                            ss += v[0] * v[0] + v[1] * v[1] + v[2] * v[2] + v[3] * v[3]; }
                        ss += __shfl_xor(ss, 16); ss += __shfl_xor(ss, 32);
                        if (fq == 0) { if (cb < 768) ssq[(size_t)row * 8 + ((cb - 512) >> 5)] = ss; else sskv[(size_t)row * 4 + ((cb - 768) >> 5)] = ss; }
                    } else if (cb == 896) {
                        const int b = tok_b(row);
                        const int pos = row < NLAT ? 256 + (row & 8191) : ((row - NLAT) & 255);
#pragma unroll
                        for (int n = 0; n < 2; ++n) { f32x4 v = acc[ai][bj][m][n]; const int d0 = n * 16 + 4 * fq;
                            if (row < NLAT) rope4(v, rope + ((size_t)(row & 8191) * 16 + (d0 >> 1)) * 2);
                            const u32x2 w = pack4(v);
#pragma unroll
                            for (int h = 0; h < 8; ++h) *(u32x2*)(KC + ((size_t)(b * 8 + h) * LK + pos) * 96 + 64 + d0) = w; }
                    }
                }
            }
    }
};

struct EpiQ {
    u16* Q; const float* ssq; const float* rope;
    DI void operator()(const AccT& acc, const Unit& u, int wr, int wc, int fr, int fq) const {
        const float qs = 0.10206207261596577f * 1.4426950408889634f;
#pragma unroll
        for (int ai = 0; ai < 2; ++ai)
#pragma unroll
            for (int m = 0; m < 4; ++m) {
                const int row = EPI_ROW(u, ai, m);
                const f32x4 sa = *(const f32x4*)(ssq + (size_t)row * 8), sb = *(const f32x4*)(ssq + (size_t)row * 8 + 4);
                const float rstd = rsqrtf((((sa[0] + sa[1]) + (sa[2] + sa[3])) + ((sb[0] + sb[1]) + (sb[2] + sb[3]))) * (1.f / 256.f) + EPS) * qs;
                const int b = tok_b(row);
#pragma unroll
                for (int bj = 0; bj < 2; ++bj)
#pragma unroll
                    for (int n = 0; n < 2; ++n) {
                        const int col = EPI_COLBASE(u, bj) + n * 16 + 4 * fq, h = col / 96, dd = col - h * 96;
                        f32x4 v = acc[ai][bj][m][n];
                        if (dd >= 64 && row < NLAT) rope4(v, rope + ((size_t)(row & 8191) * 16 + ((dd - 64) >> 1)) * 2);
                        v = v * rstd;
                        u16* dst = row < NLAT ? Q + ((size_t)(b * 8 + h) * SEQ + (row & 8191)) * 96 + dd
                                              : Q + (size_t)NLAT * 768 + ((size_t)(b * 8 + h) * CTXL + ((row - NLAT) & 255)) * 96 + dd;
                        *(u32x2*)dst = pack4(v);
                    }
            }
    }
};

struct EpiKV {
    u16* KC; u16* VT; const float* sskv;
    DI void operator()(const AccT& acc, const Unit& u, int wr, int wc, int fr, int fq) const {
#pragma unroll
        for (int ai = 0; ai < 2; ++ai)
#pragma unroll
            for (int m = 0; m < 4; ++m) {
                const int row = EPI_ROW(u, ai, m);
                const f32x4 sa = *(const f32x4*)(sskv + (size_t)row * 4);
                const float rstd = rsqrtf(((sa[0] + sa[1]) + (sa[2] + sa[3])) * (1.f / 128.f) + EPS);
                const int b = tok_b(row);
                const int pos = row < NLAT ? 256 + (row & 8191) : ((row - NLAT) & 255);
#pragma unroll
                for (int bj = 0; bj < 2; ++bj)
#pragma unroll
                    for (int n = 0; n < 2; ++n) {
                        const int col = EPI_COLBASE(u, bj) + n * 16 + 4 * fq, h = col >> 7, c2 = col & 127;
                        const f32x4 v = acc[ai][bj][m][n] * rstd;
                        if (c2 < 64) *(u32x2*)(KC + ((size_t)(b * 8 + h) * LK + pos) * 96 + c2) = pack4(v);
                        else {
#pragma unroll
                            for (int j = 0; j < 4; ++j) VT[((size_t)(b * 8 + h) * 64 + (c2 - 64 + j)) * LK + pos] = f2bf(v[j]);
                        }
                    }
            }
    }
};

struct EpiGlu {
    const u16* Z; u16* HB;
    DI void operator()(const AccT& acc, const Unit& u, int wr, int wc, int fr, int fq) const {
#pragma unroll
        for (int ai = 0; ai < 2; ++ai)
#pragma unroll
            for (int m = 0; m < 4; ++m) {
                const int row = EPI_ROW(u, ai, m);
#pragma unroll
                for (int bj = 0; bj < 2; ++bj)
#pragma unroll
                    for (int n = 0; n < 2; ++n) {
                        const int col = EPI_COLBASE(u, bj) + n * 16 + 4 * fq;
                        const u32x2 z = *(const u32x2*)(Z + (size_t)row * 512 + col);
                        const f32x4 a = acc[ai][bj][m][n];
                        f32x4 o; o[0] = bflo(z.x) * sigmoidf_(a[0]); o[1] = bfhi(z.x) * sigmoidf_(a[1]); o[2] = bflo(z.y) * sigmoidf_(a[2]); o[3] = bfhi(z.y) * sigmoidf_(a[3]);
                        *(u32x2*)(HB + (size_t)row * 1024 + col) = pack4(o);
                    }
            }
    }
};

struct EpiRes {
    const float* srcLat; const float* srcCtx; const float* gate  ; float* X; float* part;
    DI void operator()(const AccT& acc, const Unit& u, int wr, int wc, int fr, int fq) const {
#pragma unroll
        for (int ai = 0; ai < 2; ++ai)
#pragma unroll
            for (int m = 0; m < 4; ++m) {
                const int row = EPI_ROW(u, ai, m);
                if (u.ks >= 0) {
                    float* pr = part + ((size_t)u.ks * NCTX + (row - NLAT)) * 1024;
#pragma unroll
                    for (int bj = 0; bj < 2; ++bj)
#pragma unroll
                        for (int n = 0; n < 2; ++n) *(f32x4*)(pr + EPI_COLBASE(u, bj) + n * 16 + 4 * fq) = acc[ai][bj][m][n];
                } else {
                    const float* src = row < NLAT ? srcLat + (size_t)row * 1024 : srcCtx + (size_t)(row - NLAT) * 1024;
                    const float* gv = gate + tok_bidx(row) * 6144;
#pragma unroll
                    for (int bj = 0; bj < 2; ++bj)
#pragma unroll
                        for (int n = 0; n < 2; ++n) {
                            const int col = EPI_COLBASE(u, bj) + n * 16 + 4 * fq;
                            const f32x4 s = *(const f32x4*)(src + col), gg = *(const f32x4*)(gv + col);
                            *(f32x4*)(X + (size_t)row * 1024 + col) = s + gg * acc[ai][bj][m][n];
                        }
                }
            }
    }
};

struct EpiFFN1 {
    u16* ACT;
    DI void operator()(const AccT& acc, const Unit& u, int wr, int wc, int fr, int fq) const {
#pragma unroll
        for (int ai = 0; ai < 2; ++ai)
#pragma unroll
            for (int m = 0; m < 4; ++m) {
                const int row = EPI_ROW(u, ai, m);
#pragma unroll
                for (int bj = 0; bj < 2; ++bj) {
                    const int col = (EPI_COLBASE(u, bj) >> 1) + 4 * fq;
                    const f32x4 g = acc[ai][bj][m][0], up = acc[ai][bj][m][1];
                    f32x4 o; o[0] = siluf_(g[0]) * up[0]; o[1] = siluf_(g[1]) * up[1]; o[2] = siluf_(g[2]) * up[2]; o[3] = siluf_(g[3]) * up[3];
                    *(u32x2*)(ACT + (size_t)row * DFF + col) = pack4(o);
                }
            }
    }
};

struct EpiInOdd {
    u16* PROJ; const float* rope;
    DI void operator()(const AccT& acc, const Unit& u, int wr, int wc, int fr, int fq) const {
#pragma unroll
        for (int ai = 0; ai < 2; ++ai)
#pragma unroll
            for (int m = 0; m < 4; ++m) {
                const int row = EPI_ROW(u, ai, m);
#pragma unroll
                for (int bj = 0; bj < 2; ++bj) {
                    const int cb = EPI_COLBASE(u, bj), seg = cb >> 9;
#pragma unroll
                    for (int n = 0; n < 2; ++n) {
                        const int col = cb + n * 16 + 4 * fq;
                        f32x4 v = acc[ai][bj][m][n];
                        if (seg < 2) {
                            if (row < NLAT) rope4(v, rope + ((size_t)(row & 8191) * 64 + ((col & 127) >> 1)) * 2);
                            if (seg == 1) v = v * 0.08838834764831845f;
                        }
                        *(u32x2*)(PROJ + (size_t)row * 4608 + col) = pack4(v);
                    }
                }
            }
    }
};

struct ConvJob { const float* src; u16* dst; const float* rowscale; int K, N, lds_, Npad, ldd, koff, inter; };
DI void conv_job(const ConvJob& J, float* tile) {
    const int tid = tidx(), ntn = J.Npad / 64, tiles = (J.K / 64) * ntn;
    for (int t = blockIdx.x; t < tiles; t += gridDim.x) {
        const int kt = t / ntn, nt = t - kt * ntn;
#pragma unroll
        for (int i = 0; i < 8; ++i) {
            const int kl = (tid >> 6) + 8 * i, nl = tid & 63, k = kt * 64 + kl, n = nt * 64 + nl;
            float v = 0.f;
            if (n < J.N) { v = J.src[(size_t)k * J.lds_ + n]; if (J.rowscale) v *= J.rowscale[k]; }
            tile[kl * 65 + nl] = v;
        }
        __syncthreads();
#pragma unroll
        for (int i = 0; i < 8; ++i) {
            const int nl = (tid >> 6) + 8 * i, kl = tid & 63, n = nt * 64 + nl;
            const int drow = J.inter ? (32 * (n >> 4) + (n & 15) + (J.inter == 2 ? 16 : 0)) : n;
            J.dst[(size_t)drow * J.ldd + J.koff + kt * 64 + kl] = f2bf(tile[kl * 65 + nl]);
        }
        __syncthreads();
    }
}
DI void conv_mixer_weights(const Params& p, int li, float* tile) {
    unsigned char* W = p.ws + OFF_WMIX;
    const int j = li >> 1;
    if ((li & 1) == 0) {
        ConvJob a{p.in[11] + (size_t)j * 1024 * 928, (u16*)(W + WE_IN), nullptr, 1024, 928, 928, 1024, 1024, 0, 0}; conv_job(a, tile);
        ConvJob b{p.in[12] + (size_t)j * 1024 * 1024, (u16*)(W + WE_OUT), nullptr, 1024, 1024, 1024, 1024, 1024, 0, 0}; conv_job(b, tile);
        ConvJob c{p.in[21] + (size_t)j * 512 * 512, (u16*)(W + WE_GLU), nullptr, 512, 512, 512, 512, 512, 0, 0}; conv_job(c, tile);
        ConvJob d{p.in[23] + (size_t)j * 256 * 768, (u16*)(W + WE_UQ), p.in[22] + j * 256, 256, 768, 768, 768, 256, 0, 0}; conv_job(d, tile);
        ConvJob e{p.in[25] + (size_t)j * 128 * 1024, (u16*)(W + WE_UKV), p.in[24] + j * 128, 128, 1024, 1024, 1024, 256, 128, 0}; conv_job(e, tile);
        u16* z = (u16*)(W + WE_UKV);
        for (int i = blockIdx.x * 512 + tidx(); i < 1024 * 128; i += gridDim.x * 512) z[(size_t)(i >> 7) * 256 + (i & 127)] = 0;
    } else {
        ConvJob a{p.in[26] + (size_t)j * 1024 * 4608, (u16*)(W + WO_IN), nullptr, 1024, 4608, 4608, 4608, 1024, 0, 0}; conv_job(a, tile);
        ConvJob b{p.in[27] + (size_t)j * 1024 * 1024, (u16*)(W + WO_OUT), nullptr, 1024, 1024, 1024, 1024, 1024, 0, 0}; conv_job(b, tile);
    }
}
DI void conv_ffn_weights(const Params& p, int li, float* tile) {
    unsigned char* W = p.ws + OFF_WFFN;
    ConvJob a{p.in[8] + (size_t)li * 1024 * DFF, (u16*)(W + WF_13), nullptr, 1024, DFF, DFF, DFF, 1024, 0, 1}; conv_job(a, tile);
    ConvJob b{p.in[9] + (size_t)li * 1024 * DFF, (u16*)(W + WF_13), nullptr, 1024, DFF, DFF, DFF, 1024, 0, 2}; conv_job(b, tile);
    ConvJob c{p.in[10] + (size_t)li * DFF * 1024, (u16*)(W + WF_2), nullptr, DFF, 1024, 1024, 1024, DFF, 0, 0}; conv_job(c, tile);
}

DI void norm_rows(const float* srcLat, const float* srcCtx, const float* g, const float* modl, int aoff, int soff, u16* H,
                  const float* part, int KS, const float* gctx, float* xw) {
    const int wid = tidx() >> 6, lane = tidx() & 63;
    for (int row = blockIdx.x * 8 + wid; row < NTOK; row += gridDim.x * 8) {
        const float* src = row < NLAT ? srcLat + (size_t)row * 1024 : srcCtx + (size_t)(row - NLAT) * 1024;
        const float* mv = modl + tok_bidx(row) * 6144;
        f32x4 v[4]; float ss = 0.f;
#pragma unroll
        for (int i = 0; i < 4; ++i) v[i] = *(const f32x4*)(src + i * 256 + lane * 4);
        if (part != nullptr && row >= NLAT) {
#pragma unroll
            for (int i = 0; i < 4; ++i) { const int col = i * 256 + lane * 4; f32x4 a = (f32x4){0.f, 0.f, 0.f, 0.f};
                for (int k = 0; k < KS; ++k) a += *(const f32x4*)(part + ((size_t)k * NCTX + (row - NLAT)) * 1024 + col);
                v[i] += *(const f32x4*)(gctx + col) * a;
                *(f32x4*)(xw + (size_t)row * 1024 + col) = v[i]; }
        }
#pragma unroll
        for (int i = 0; i < 4; ++i) ss += v[i][0] * v[i][0] + v[i][1] * v[i][1] + v[i][2] * v[i][2] + v[i][3] * v[i][3];
#pragma unroll
        for (int o = 1; o < 64; o <<= 1) ss += __shfl_xor(ss, o);
        const float rstd = rsqrtf(ss * (1.f / 1024.f) + EPS);
#pragma unroll
        for (int i = 0; i < 4; ++i) {
            const int col = i * 256 + lane * 4;
            const f32x4 gg = *(const f32x4*)(g + col), a = *(const f32x4*)(mv + aoff + col), s = *(const f32x4*)(mv + soff + col);
            const f32x4 h = v[i] * rstd * gg * (a + 1.f) + s;
            *(u32x2*)(H + (size_t)row * 1024 + col) = pack4(h);
        }
    }
}
DI void final_norm_rows(const float* X, const float* g, float* out) {
    const int wid = tidx() >> 6, lane = tidx() & 63;
    for (int row = blockIdx.x * 8 + wid; row < NLAT; row += gridDim.x * 8) {
        const float* src = X + (size_t)row * 1024;
        f32x4 v[4]; float ss = 0.f;
#pragma unroll
        for (int i = 0; i < 4; ++i) { v[i] = *(const f32x4*)(src + i * 256 + lane * 4); ss += v[i][0] * v[i][0] + v[i][1] * v[i][1] + v[i][2] * v[i][2] + v[i][3] * v[i][3]; }
#pragma unroll
        for (int o = 1; o < 64; o <<= 1) ss += __shfl_xor(ss, o);
        const float rstd = rsqrtf(ss * (1.f / 1024.f) + EPS);
#pragma unroll
        for (int i = 0; i < 4; ++i) { const int col = i * 256 + lane * 4; *(f32x4*)(out + (size_t)row * 1024 + col) = v[i] * rstd * *(const f32x4*)(g + col); }
    }
}

DI void prep_phase(const Params& p, float* ldsf) {
    const int tid = tidx(), gt = blockIdx.x * 512 + tid, gs = gridDim.x * 512;
    float* mod = (float*)(p.ws + OFF_MOD);
    {
        for (int i = tid; i < 3072; i += 512) { const int v = i >> 10, k = i & 1023; const float x = v < 2 ? p.in[1][v * 1024 + k] : p.in[3][k]; ldsf[i] = siluf_(x); }
        __syncthreads();
        for (int u = blockIdx.x; u < 4 * 12 * 16; u += gridDim.x) {
            const int ks = u & 15, cbk = (u >> 4) % 12, li = u / 192, n = cbk * 512 + tid, k0 = ks * 64;
            const float* w = p.in[4] + ((size_t)li * 1024 + k0) * 6144 + n;
            float a0 = 0.f, a1 = 0.f, a2 = 0.f;
#pragma unroll 16
            for (int k = 0; k < 64; ++k) { const float wv = w[(size_t)k * 6144]; a0 += ldsf[k0 + k] * wv; a1 += ldsf[1024 + k0 + k] * wv; a2 += ldsf[2048 + k0 + k] * wv; }
            if (ks == 0) { const float bm = p.in[5][li * 6144 + n]; a0 += bm; a1 += bm; a2 += bm; }
            float* mp = (float*)(p.ws + OFF_MODP) + (size_t)ks * (4 * 3 * 6144);
            mp[(li * 3 + 0) * 6144 + n] = a0; mp[(li * 3 + 1) * 6144 + n] = a1; mp[(li * 3 + 2) * 6144 + n] = a2;
        }
        __syncthreads();
    }
    float* rm = (float*)(p.ws + OFF_RMLA); float* rr = (float*)(p.ws + OFF_RRET);
    for (int i = gt; i < 8192 * 16; i += gs) { const int l = i >> 4, q = i & 15, r = l >> 6, c = l & 63;
        const float inv = powf(10000.f, -(float)(q & 7) / 8.f); const float ang = (float)(q < 8 ? r : c) * inv;
        float sn, cs; sincosf(ang, &sn, &cs); rm[2 * i] = cs; rm[2 * i + 1] = sn; }
    for (int i = gt; i < 8192 * 64; i += gs) { const int l = i >> 6, q = i & 63, r = l >> 6, c = l & 63;
        const float inv = powf(10000.f, -(float)(q & 31) / 32.f); const float ang = (float)(q < 32 ? r : c) * inv;
        float sn, cs; sincosf(ang, &sn, &cs); rr[2 * i] = cs; rr[2 * i + 1] = sn; }
    float* lb = (float*)(p.ws + OFF_LB);
    for (int i = gt; i < 512; i += gs) { const float a = p.in[29][i], b = p.in[29][512 + i], c = p.in[29][1024 + i]; const float mx = fmaxf(a, fmaxf(b, c));
        const float ea = expf(a - mx), eb = expf(b - mx), ec = expf(c - mx), s = ea + eb + ec; lb[i] = ea / s; lb[512 + i] = (ea + eb) / s; }
    float2* sab = (float2*)(p.ws + OFF_SAB); float2* sa64 = (float2*)(p.ws + OFF_SA64); float2* sbb = (float2*)(p.ws + OFF_SBB); u16* scc = (u16*)(p.ws + OFF_SCC);
    for (int i = gt; i < 2 * 2 * 2048; i += gs) {
        const int gp = i & 2047, jr = i >> 11, g = gp >> 6, pp = gp & 63;
        const double are = p.in[13][i], aim = p.in[14][i], dt = exp((double)p.in[15][jr * 32 + g]);
        const double mag = exp(are * dt), abr = mag * cos(aim * dt), abi = mag * sin(aim * dt);
        sab[i] = make_float2((float)abr, (float)abi);
        const double m64 = exp(are * dt * 64.0); sa64[i] = make_float2((float)(m64 * cos(aim * dt * 64.0)), (float)(m64 * sin(aim * dt * 64.0)));
        const double nr = abr - 1.0, ni = abi, den = are * are + aim * aim;
        const double fr = (nr * are + ni * aim) / den, fi = (ni * are - nr * aim) / den;
        { u16* sbbt = (u16*)sbb;
          for (int k = 0; k < 16; ++k) { const double br = p.in[16][(size_t)i * 16 + k], bi = p.in[17][(size_t)i * 16 + k];
            sbbt[((size_t)(jr * 32 + g) * 128 + pp) * 16 + k] = f2bf((float)(fr * br - fi * bi));
            sbbt[((size_t)(jr * 32 + g) * 128 + 64 + pp) * 16 + k] = f2bf((float)(fr * bi + fi * br)); } }
        for (int k = 0; k < 16; ++k) { const size_t ci = ((size_t)(jr * 32 + g) * 16 + k) * 64 + pp;
            scc[((size_t)(jr * 32 + g) * 16 + k) * 128 + pp] = f2bf(p.in[18][ci]); scc[((size_t)(jr * 32 + g) * 16 + k) * 128 + 64 + pp] = f2bf(-p.in[19][ci]); }
    }
    conv_mixer_weights(p, 0, ldsf);
}

constexpr int AT_KROW = 208, AT_VROW = 144, AT_KBUF = 64 * AT_KROW, AT_VBUF = 64 * AT_VROW, AT_BUF = AT_KBUF + AT_VBUF;
DI void attn_unit(LAS unsigned char* lds, const u16* Qp, const u16* Kp, const u16* Vp, int nkt, u16* outp) {
    const int tid = tidx(), wid = tid >> 6, lane = tid & 63, l31 = lane & 31, hh = lane >> 5;
    bf16x8 qf[6];
    { const u16* qr = Qp + (size_t)(wid * 32 + l31) * 96 + 8 * hh;
#pragma unroll
      for (int s = 0; s < 6; ++s) qf[s] = *(const bf16x8*)(qr + 16 * s); }
    f32x16 o0, o1;
#pragma unroll
    for (int i = 0; i < 16; ++i) { o0[i] = 0.f; o1[i] = 0.f; }
    float m_run = -1e30f, lsum = 0.f;
    const int kr0 = tid / 12, kp0 = tid - kr0 * 12, c1 = 512 + tid, kr1 = c1 / 12, kp1 = c1 - kr1 * 12, vr = tid >> 3, vp = tid & 7;
    u32x4 rk0, rk1 = (u32x4){0u, 0u, 0u, 0u}, rv;
    rk0 = *(const u32x4*)(Kp + (size_t)kr0 * 96 + kp0 * 8);
    if (tid < 256) rk1 = *(const u32x4*)(Kp + (size_t)kr1 * 96 + kp1 * 8);
    rv = *(const u32x4*)(Vp + (size_t)vr * LK + vp * 8);
    *(LAS u32x4*)(lds + kr0 * AT_KROW + kp0 * 16) = rk0;
    if (tid < 256) *(LAS u32x4*)(lds + kr1 * AT_KROW + kp1 * 16) = rk1;
    *(LAS u32x4*)(lds + AT_KBUF + vr * AT_VROW + vp * 16) = rv;
    __syncthreads();
    for (int kt = 0; kt < nkt; ++kt) {
        LAS unsigned char* kb_ = lds + (kt & 1) * AT_BUF; LAS unsigned char* vb_ = kb_ + AT_KBUF;
        const bool more = kt + 1 < nkt;
        if (more) { const u16* kn = Kp + (size_t)(kt + 1) * 64 * 96; const u16* vn = Vp + (size_t)(kt + 1) * 64;
            rk0 = *(const u32x4*)(kn + (size_t)kr0 * 96 + kp0 * 8);
            if (tid < 256) rk1 = *(const u32x4*)(kn + (size_t)kr1 * 96 + kp1 * 8);
            rv = *(const u32x4*)(vn + (size_t)vr * LK + vp * 8); }
        f32x16 st0, st1;
#pragma unroll
        for (int i = 0; i < 16; ++i) { st0[i] = 0.f; st1[i] = 0.f; }
#pragma unroll
        for (int s = 0; s < 6; ++s) {
            const bf16x8 a0 = *(const LAS bf16x8*)(kb_ + l31 * AT_KROW + (16 * s + 8 * hh) * 2);
            const bf16x8 a1 = *(const LAS bf16x8*)(kb_ + (32 + l31) * AT_KROW + (16 * s + 8 * hh) * 2);
            st0 = MFMA32(a0, qf[s], st0); st1 = MFMA32(a1, qf[s], st1);
        }
        float mx = st0[0];
#pragma unroll
        for (int i = 0; i < 16; ++i) { mx = fmaxf(mx, st0[i]); mx = fmaxf(mx, st1[i]); }
        mx = fmaxf(mx, __shfl_xor(mx, 32));
        const float m_new = fmaxf(m_run, mx), alpha = __builtin_amdgcn_exp2f(m_run - m_new);
        m_run = m_new;
        float ps = 0.f;
#pragma unroll
        for (int i = 0; i < 16; ++i) { st0[i] = __builtin_amdgcn_exp2f(st0[i] - m_new); st1[i] = __builtin_amdgcn_exp2f(st1[i] - m_new); ps += st0[i] + st1[i]; }
        lsum = lsum * alpha + ps;
#pragma unroll
        for (int i = 0; i < 16; ++i) { o0[i] *= alpha; o1[i] *= alpha; }
#pragma unroll
        for (int kb = 0; kb < 2; ++kb)
#pragma unroll
            for (int s = 0; s < 2; ++s) {
                u32x4 pw;
                if (kb == 0) { pw.x = pk2(st0[8 * s], st0[8 * s + 1]); pw.y = pk2(st0[8 * s + 2], st0[8 * s + 3]); pw.z = pk2(st0[8 * s + 4], st0[8 * s + 5]); pw.w = pk2(st0[8 * s + 6], st0[8 * s + 7]); }
                else         { pw.x = pk2(st1[8 * s], st1[8 * s + 1]); pw.y = pk2(st1[8 * s + 2], st1[8 * s + 3]); pw.z = pk2(st1[8 * s + 4], st1[8 * s + 5]); pw.w = pk2(st1[8 * s + 6], st1[8 * s + 7]); }
                const bf16x8 pb = __builtin_bit_cast(bf16x8, pw);
                const int koff = (32 * kb + 16 * s + 4 * hh) * 2;
                { const u32x2 lo = *(const LAS u32x2*)(vb_ + l31 * AT_VROW + koff), hi = *(const LAS u32x2*)(vb_ + l31 * AT_VROW + koff + 16);
                  u32x4 va; va.x = lo.x; va.y = lo.y; va.z = hi.x; va.w = hi.y; o0 = MFMA32(__builtin_bit_cast(bf16x8, va), pb, o0); }
                { const u32x2 lo = *(const LAS u32x2*)(vb_ + (32 + l31) * AT_VROW + koff), hi = *(const LAS u32x2*)(vb_ + (32 + l31) * AT_VROW + koff + 16);
                  u32x4 va; va.x = lo.x; va.y = lo.y; va.z = hi.x; va.w = hi.y; o1 = MFMA32(__builtin_bit_cast(bf16x8, va), pb, o1); }
            }
        if (more) { LAS unsigned char* nb = lds + ((kt + 1) & 1) * AT_BUF;
            *(LAS u32x4*)(nb + kr0 * AT_KROW + kp0 * 16) = rk0;
            if (tid < 256) *(LAS u32x4*)(nb + kr1 * AT_KROW + kp1 * 16) = rk1;
            *(LAS u32x4*)(nb + AT_KBUF + vr * AT_VROW + vp * 16) = rv; }
        __syncthreads();
    }
    const float lt = lsum + __shfl_xor(lsum, 32), inv = 1.f / lt;
    u16* orow = outp + (size_t)(wid * 32 + l31) * 1024;
#pragma unroll
    for (int g = 0; g < 4; ++g) {
        u32x2 w0, w1;
        w0.x = pk2(o0[4 * g] * inv, o0[4 * g + 1] * inv); w0.y = pk2(o0[4 * g + 2] * inv, o0[4 * g + 3] * inv);
        w1.x = pk2(o1[4 * g] * inv, o1[4 * g + 1] * inv); w1.y = pk2(o1[4 * g + 2] * inv, o1[4 * g + 3] * inv);
        *(u32x2*)(orow + 8 * g + 4 * hh) = w0; *(u32x2*)(orow + 32 + 8 * g + 4 * hh) = w1;
    }
}


DI void attn_unit64(LAS unsigned char* lds, const u16* Qp, const u16* Kp, const u16* Vp, int nkt, u16* outp) {
    const int tid = tidx(), wid = tid >> 6, lane = tid & 63, l31 = lane & 31, hh = lane >> 5;
    bf16x8 qf0[6], qf1[6];
    { const u16* qr = Qp + (size_t)(wid * 64 + l31) * 96 + 8 * hh;
#pragma unroll
      for (int s = 0; s < 6; ++s) { qf0[s] = *(const bf16x8*)(qr + 16 * s); qf1[s] = *(const bf16x8*)(qr + 32 * 96 + 16 * s); } }
    f32x16 oa0, oa1, ob0, ob1;
#pragma unroll
    for (int i = 0; i < 16; ++i) { oa0[i] = 0.f; oa1[i] = 0.f; ob0[i] = 0.f; ob1[i] = 0.f; }
    float ma = -1e30f, mb = -1e30f, la = 0.f, lb = 0.f;
    const int kr0 = tid / 12, kp0 = tid - kr0 * 12, c1 = 512 + tid, kr1 = c1 / 12, kp1 = c1 - kr1 * 12, vr = tid >> 3, vp = tid & 7;
    u32x4 rk0, rk1 = (u32x4){0u, 0u, 0u, 0u}, rv;
    rk0 = *(const u32x4*)(Kp + (size_t)kr0 * 96 + kp0 * 8);
    if (tid < 256) rk1 = *(const u32x4*)(Kp + (size_t)kr1 * 96 + kp1 * 8);
    rv = *(const u32x4*)(Vp + (size_t)vr * LK + vp * 8);
    *(LAS u32x4*)(lds + kr0 * AT_KROW + kp0 * 16) = rk0;
    if (tid < 256) *(LAS u32x4*)(lds + kr1 * AT_KROW + kp1 * 16) = rk1;
    *(LAS u32x4*)(lds + AT_KBUF + vr * AT_VROW + vp * 16) = rv;
    __syncthreads();
    for (int kt = 0; kt < nkt; ++kt) {
        LAS unsigned char* kb_ = lds + (kt & 1) * AT_BUF; LAS unsigned char* vb_ = kb_ + AT_KBUF;
        const bool more = kt + 1 < nkt;
        if (more) { const u16* kn = Kp + (size_t)(kt + 1) * 64 * 96; const u16* vn = Vp + (size_t)(kt + 1) * 64;
            rk0 = *(const u32x4*)(kn + (size_t)kr0 * 96 + kp0 * 8);
            if (tid < 256) rk1 = *(const u32x4*)(kn + (size_t)kr1 * 96 + kp1 * 8);
            rv = *(const u32x4*)(vn + (size_t)vr * LK + vp * 8); }
        f32x16 sa0, sa1, sb0, sb1;
#pragma unroll
        for (int i = 0; i < 16; ++i) { sa0[i] = 0.f; sa1[i] = 0.f; sb0[i] = 0.f; sb1[i] = 0.f; }
#pragma unroll
        for (int s = 0; s < 6; ++s) {
            const bf16x8 a0 = *(const LAS bf16x8*)(kb_ + l31 * AT_KROW + (16 * s + 8 * hh) * 2);
            const bf16x8 a1 = *(const LAS bf16x8*)(kb_ + (32 + l31) * AT_KROW + (16 * s + 8 * hh) * 2);
            sa0 = MFMA32(a0, qf0[s], sa0); sa1 = MFMA32(a1, qf0[s], sa1);
            sb0 = MFMA32(a0, qf1[s], sb0); sb1 = MFMA32(a1, qf1[s], sb1);
        }
        u32x4 pa[4], pb[4];
#define AT_SOFTMAX(S0, S1, M, L, O0, O1, P) do { \
        float mx = S0[0]; \
        _Pragma("unroll") for (int i = 0; i < 16; ++i) { mx = fmaxf(mx, S0[i]); mx = fmaxf(mx, S1[i]); } \
        { const auto sw_ = __builtin_amdgcn_permlane32_swap(__float_as_uint(mx), __float_as_uint(mx), false, false); \
          mx = fmaxf(__uint_as_float(sw_[0]), __uint_as_float(sw_[1])); }     \
        const float m_new = fmaxf(M, mx); \
        if (__builtin_amdgcn_ballot_w64(mx > M + 8.0f) != 0ull) {     const float alpha = __builtin_amdgcn_exp2f(M - m_new); M = m_new; L *= alpha; \
            _Pragma("unroll") for (int i = 0; i < 16; ++i) { O0[i] *= alpha; O1[i] *= alpha; } } \
        float ps = 0.f; \
        _Pragma("unroll") for (int i = 0; i < 16; ++i) { S0[i] = __builtin_amdgcn_exp2f(S0[i] - M); S1[i] = __builtin_amdgcn_exp2f(S1[i] - M); ps += S0[i] + S1[i]; } \
        L += ps; \
        _Pragma("unroll") for (int s = 0; s < 2; ++s) { \
            P[s].x = pk2(S0[8 * s], S0[8 * s + 1]); P[s].y = pk2(S0[8 * s + 2], S0[8 * s + 3]); P[s].z = pk2(S0[8 * s + 4], S0[8 * s + 5]); P[s].w = pk2(S0[8 * s + 6], S0[8 * s + 7]); \
            P[2 + s].x = pk2(S1[8 * s], S1[8 * s + 1]); P[2 + s].y = pk2(S1[8 * s + 2], S1[8 * s + 3]); P[2 + s].z = pk2(S1[8 * s + 4], S1[8 * s + 5]); P[2 + s].w = pk2(S1[8 * s + 6], S1[8 * s + 7]); } \
        } while (0)
        AT_SOFTMAX(sa0, sa1, ma, la, oa0, oa1, pa);
        AT_SOFTMAX(sb0, sb1, mb, lb, ob0, ob1, pb);
#undef AT_SOFTMAX
#pragma unroll
        for (int kb = 0; kb < 2; ++kb)
#pragma unroll
            for (int s = 0; s < 2; ++s) {
                const int koff = (32 * kb + 16 * s + 4 * hh) * 2;
                const u32x2 lo0 = *(const LAS u32x2*)(vb_ + l31 * AT_VROW + koff), hi0 = *(const LAS u32x2*)(vb_ + l31 * AT_VROW + koff + 16);
                const u32x2 lo1 = *(const LAS u32x2*)(vb_ + (32 + l31) * AT_VROW + koff), hi1 = *(const LAS u32x2*)(vb_ + (32 + l31) * AT_VROW + koff + 16);
                u32x4 va0, va1; va0.x = lo0.x; va0.y = lo0.y; va0.z = hi0.x; va0.w = hi0.y; va1.x = lo1.x; va1.y = lo1.y; va1.z = hi1.x; va1.w = hi1.y;
                const bf16x8 v0 = __builtin_bit_cast(bf16x8, va0), v1 = __builtin_bit_cast(bf16x8, va1);
                const bf16x8 pA = __builtin_bit_cast(bf16x8, pa[kb * 2 + s]), pB = __builtin_bit_cast(bf16x8, pb[kb * 2 + s]);
                oa0 = MFMA32(v0, pA, oa0); oa1 = MFMA32(v1, pA, oa1);
                ob0 = MFMA32(v0, pB, ob0); ob1 = MFMA32(v1, pB, ob1);
            }
        if (more) { LAS unsigned char* nb = lds + ((kt + 1) & 1) * AT_BUF;
            *(LAS u32x4*)(nb + kr0 * AT_KROW + kp0 * 16) = rk0;
            if (tid < 256) *(LAS u32x4*)(nb + kr1 * AT_KROW + kp1 * 16) = rk1;
            *(LAS u32x4*)(nb + AT_KBUF + vr * AT_VROW + vp * 16) = rv; }
        __syncthreads();
    }
    {   const float lt = la + __shfl_xor(la, 32), inv = 1.f / lt;
        u16* orow = outp + (size_t)(wid * 64 + l31) * 1024;
#pragma unroll
        for (int g = 0; g < 4; ++g) { u32x2 w0, w1;
            w0.x = pk2(oa0[4 * g] * inv, oa0[4 * g + 1] * inv); w0.y = pk2(oa0[4 * g + 2] * inv, oa0[4 * g + 3] * inv);
            w1.x = pk2(oa1[4 * g] * inv, oa1[4 * g + 1] * inv); w1.y = pk2(oa1[4 * g + 2] * inv, oa1[4 * g + 3] * inv);
            *(u32x2*)(orow + 8 * g + 4 * hh) = w0; *(u32x2*)(orow + 32 + 8 * g + 4 * hh) = w1; } }
    {   const float lt = lb + __shfl_xor(lb, 32), inv = 1.f / lt;
        u16* orow = outp + (size_t)(wid * 64 + 32 + l31) * 1024;
#pragma unroll
        for (int g = 0; g < 4; ++g) { u32x2 w0, w1;
            w0.x = pk2(ob0[4 * g] * inv, ob0[4 * g + 1] * inv); w0.y = pk2(ob0[4 * g + 2] * inv, ob0[4 * g + 3] * inv);
            w1.x = pk2(ob1[4 * g] * inv, ob1[4 * g + 1] * inv); w1.y = pk2(ob1[4 * g + 2] * inv, ob1[4 * g + 3] * inv);
            *(u32x2*)(orow + 8 * g + 4 * hh) = w0; *(u32x2*)(orow + 32 + 8 * g + 4 * hh) = w1; } }
}

DI int s5_rowbase(int b, int jc) { return jc < 4 ? NLAT + b * 256 + jc * 64 : b * 8192 + (jc - 4) * 64; }
constexpr int S5_BU = 16 * 132 * 4, S5_HB = 16 * 136 * 2, S5_WAVE = S5_BU + S5_HB;
#define S5_WAVE_SYNC() do { asm volatile("s_waitcnt vmcnt(0) lgkmcnt(0)" ::: "memory"); __builtin_amdgcn_wave_barrier(); } while (0)
template <bool WITH_C>
DI void s5_dir(const Params& p, int j, int dir, int g, int rowbase, float& hr, float& hi, f32x4 (&acc)[4], unsigned char* lw) {
    const int lane = tidx() & 63, lq = lane >> 4, l15 = lane & 15, gp = g * 64 + lane;
    const int tdir = (j * 2 + dir);
    const float2 A = ((const float2*)(p.ws + OFF_SAB))[tdir * 2048 + gp];
    const u16* U = (const u16*)(p.ws + OFF_BIG + BE_U);
    const u16* sbbt = (const u16*)(p.ws + OFF_SBB) + (size_t)(tdir * 32 + g) * 128 * 16;
    const bf16x8 zero8 = (bf16x8){0, 0, 0, 0, 0, 0, 0, 0};
    bf16x8 bfr[8];
#pragma unroll
    for (int nt = 0; nt < 8; ++nt) bfr[nt] = lq < 2 ? *(const bf16x8*)(sbbt + (16 * nt + l15) * 16 + 8 * lq) : zero8;
    bf16x8 cf[4];
    if (WITH_C) { const u16* cp = (const u16*)(p.ws + OFF_SCC) + ((size_t)(tdir * 32 + g) * 16 + l15) * 128 + 8 * lq;
#pragma unroll
        for (int s = 0; s < 4; ++s) cf[s] = *(const bf16x8*)(cp + 32 * s); }
    bf16x8 ua[4];
#pragma unroll
    for (int sb = 0; sb < 4; ++sb) ua[sb] = lq < 2 ? *(const bf16x8*)(U + (size_t)(rowbase + 16 * sb + l15) * 512 + g * 16 + 8 * lq) : zero8;
    float* bu = (float*)lw; u16* hb = (u16*)(lw + S5_BU);
#pragma unroll
    for (int sbi = 0; sbi < 4; ++sbi) {
        const int sb = dir ? 3 - sbi : sbi;
#pragma unroll
        for (int nt = 0; nt < 8; ++nt) {
            const f32x4 c = MFMA16(ua[sb], bfr[nt], ((f32x4){0.f, 0.f, 0.f, 0.f}));
#pragma unroll
            for (int i = 0; i < 4; ++i) bu[(4 * lq + i) * 132 + 16 * nt + l15] = c[i];
        }
        S5_WAVE_SYNC();
        for (int tt = 0; tt < 16; ++tt) {
            const int tl = dir ? 15 - tt : tt;
            const float br = bu[tl * 132 + lane], bi = bu[tl * 132 + 64 + lane];
            const float nr = A.x * hr - A.y * hi + br, ni = A.x * hi + A.y * hr + bi; hr = nr; hi = ni;
            if (WITH_C) { hb[tl * 136 + lane] = f2bf(hr); hb[tl * 136 + 64 + lane] = f2bf(hi); }
        }
        S5_WAVE_SYNC();
        if (WITH_C) {
            f32x4 a = (f32x4){0.f, 0.f, 0.f, 0.f};
#pragma unroll
            for (int s = 0; s < 4; ++s) { const bf16x8 af = *(const bf16x8*)(hb + l15 * 136 + 32 * s + 8 * lq); a = MFMA16(af, cf[s], a); }
            acc[sb] += a;
        }
    }
}
DI void s5_pass1_unit(const Params& p, int j, int unit, unsigned char* l) {
    const int gb = unit & 3, jc = (unit >> 2) % NCH, b = (unit >> 2) / NCH;
    const int tid = tidx(), w = tid >> 6, lane = tid & 63, g = gb * 8 + w, gp = g * 64 + lane;
    float2* E = (float2*)(p.ws + OFF_BIG + BE_S5E);
    const int rowbase = s5_rowbase(b, jc);
    f32x4 acc[4];
    __syncthreads();
#pragma unroll
    for (int dir = 0; dir < 2; ++dir) {
        float hr = 0.f, hi = 0.f;
        s5_dir<false>(p, j, dir, g, rowbase, hr, hi, acc, l + w * S5_WAVE);
        E[((size_t)(b * 2 + dir) * NCH + scan_idx(jc, dir)) * 2048 + gp] = make_float2(hr, hi);
    }
}
DI void s5_carry_scan(const Params& p, int j, int wg0) {
    const int nw = (int)gridDim.x - wg0;
    if ((int)blockIdx.x < wg0) return;
    for (int gt = ((int)blockIdx.x - wg0) * 512 + tidx(); gt < 8192; gt += nw * 512) {
    const int gp = gt & 2047, bd = gt >> 11, dir = bd & 1;
    float2* Ep = (float2*)(p.ws + OFF_BIG + BE_S5E) + (size_t)bd * NCH * 2048 + gp;
    const float2 A64 = ((const float2*)(p.ws + OFF_SA64))[(j * 2 + dir) * 2048 + gp];
    float hr = 0.f, hi = 0.f; asm volatile("" : "+v"(hr), "+v"(hi));
    for (int n0 = 0; n0 < NCH; n0 += 12) {
        float2 e[12];
#pragma unroll
        for (int i = 0; i < 12; ++i) e[i] = Ep[(size_t)(n0 + i) * 2048];
#pragma unroll
        for (int i = 0; i < 12; ++i) { Ep[(size_t)(n0 + i) * 2048] = make_float2(hr, hi);
            const float nr = A64.x * hr - A64.y * hi + e[i].x, ni = A64.x * hi + A64.y * hr + e[i].y; hr = nr; hi = ni; }
    }
    }
}
DI void s5_pass2_unit(const Params& p, int j, int unit, unsigned char* l) {
    const int gb = unit & 3, jc = (unit >> 2) % NCH, b = (unit >> 2) / NCH;
    const int tid = tidx(), w = tid >> 6, lane = tid & 63, g = gb * 8 + w, gp = g * 64 + lane;
    const u16* U = (const u16*)(p.ws + OFF_BIG + BE_U);
    const float2* E = (const float2*)(p.ws + OFF_BIG + BE_S5E);
    u16* Z = (u16*)(p.ws + OFF_BIG + BE_Z);
    const int rowbase = s5_rowbase(b, jc);
    f32x4 acc[4];
#pragma unroll
    for (int i = 0; i < 4; ++i) acc[i] = (f32x4){0.f, 0.f, 0.f, 0.f};
    __syncthreads();
#pragma unroll
    for (int dir = 0; dir < 2; ++dir) {
        const float2 h0 = E[((size_t)(b * 2 + dir) * NCH + scan_idx(jc, dir)) * 2048 + gp];
        float hr = h0.x, hi = h0.y;
        s5_dir<true>(p, j, dir, g, rowbase, hr, hi, acc, l + w * S5_WAVE);
    }
    const int col = g * 16 + (lane & 15);
    const float dcoef = p.in[20][j * 512 + col];
#pragma unroll
    for (int sb = 0; sb < 4; ++sb)
#pragma unroll
        for (int i = 0; i < 4; ++i) {
            const int t = sb * 16 + 4 * (lane >> 4) + i;
            const float y = acc[sb][i] + dcoef * bf2f(U[(size_t)(rowbase + t) * 512 + col]);
            Z[(size_t)(rowbase + t) * 512 + col] = f2bf(gelu_tanh(y));
        }
}

constexpr int GL_S136 = 136, GL_S72 = 72;
constexpr int GL_CUM = 0, GL_QT = 33792, GL_KT = GL_QT + 64 * 136 * 2, GL_QS = GL_KT + 64 * 136 * 2, GL_VT = GL_QS + 64 * 136 * 2, GL_ATT = GL_VT + 128 * 72 * 2, GL_KDT = GL_ATT + 64 * 72 * 2;
DI int gla_rowbase(int b, int jc) { return jc < 4 ? NLAT + b * 256 + jc * 64 : b * 8192 + (jc - 4) * 64; }
DI void ld16(const u16* p, float* f) {
    const u32x4 a = *(const u32x4*)p, b = *(const u32x4*)(p + 8);
    f[0] = bflo(a.x); f[1] = bfhi(a.x); f[2] = bflo(a.y); f[3] = bfhi(a.y); f[4] = bflo(a.z); f[5] = bfhi(a.z); f[6] = bflo(a.w); f[7] = bfhi(a.w);
    f[8] = bflo(b.x); f[9] = bfhi(b.x); f[10] = bflo(b.y); f[11] = bfhi(b.y); f[12] = bflo(b.z); f[13] = bfhi(b.z); f[14] = bflo(b.w); f[15] = bfhi(b.w);
}
DI void gla_cum(unsigned char* l, const u16* PROJ, const float* lbv, int mixer, int h, int dir, int rowbase, float* kv) {
    const int tid = tidx(), t = tid >> 3, d0 = (tid & 7) * 16;
    float* cum = (float*)(l + GL_CUM);
    const u16* prow = PROJ + (size_t)(rowbase + t) * 4608 + h * 128 + d0;
    if (mixer == 0) {
        const float lg = log1pf(-exp2f(-(5.f + 0.5f * dir) - (float)h));
        const float c = dir ? lg * (float)(64 - t) : lg * (float)(t + 1);
#pragma unroll
        for (int i = 0; i < 16; ++i) cum[t * 128 + d0 + i] = c;
        ld16(prow + 512, kv);
        __syncthreads();
    } else {
        float x[16]; ld16(prow + (dir ? 3072 : 2560), x);
#pragma unroll
        for (int i = 0; i < 16; ++i) { const float lbd = lbv[h * 128 + d0 + i]; const float f = lbd + (1.f - lbd) * sigmoidf_(x[i]); kv[i] = 1.f - f; cum[t * 128 + d0 + i] = __logf(f); }
        __syncthreads();
        { const int q = tid >> 7, d = tid & 127; float sacc = 0.f;
          if (dir == 0) { for (int r = 16 * q; r < 16 * q + 16; ++r) { sacc += cum[r * 128 + d]; cum[r * 128 + d] = sacc; } }
          else { for (int r = 16 * q + 15; r >= 16 * q; --r) { sacc += cum[r * 128 + d]; cum[r * 128 + d] = sacc; } }
          __syncthreads();
          float off = 0.f;
          if (dir == 0) { for (int qq = 0; qq < q; ++qq) off += cum[(16 * qq + 15) * 128 + d]; }
          else { for (int qq = q + 1; qq < 4; ++qq) off += cum[(16 * qq) * 128 + d]; }
          __syncthreads();
          for (int r = 16 * q; r < 16 * q + 16; ++r) cum[r * 128 + d] += off; }
        __syncthreads();
    }
}
DI void gla_load_vt(unsigned char* l, const u16* PROJ, int mixer, int h, int rowbase) {
    const int tid = tidx(), t = tid & 63, d0 = (tid >> 6) * 16;
    u16* vt = (u16*)(l + GL_VT);
    const u16* prow = PROJ + (size_t)(rowbase + t) * 4608 + (mixer ? 3584 : 1024) + h * 128 + d0;
    const u32x4 a = *(const u32x4*)prow, b = *(const u32x4*)(prow + 8);
    const unsigned wv[8] = {a.x, a.y, a.z, a.w, b.x, b.y, b.z, b.w};
#pragma unroll
    for (int i = 0; i < 8; ++i) { vt[(d0 + 2 * i) * GL_S72 + t] = (u16)(wv[i] & 0xffffu); vt[(d0 + 2 * i + 1) * GL_S72 + t] = (u16)(wv[i] >> 16); }
}
DI void gla_pass1_unit(const Params& p, int b, int lbj, int unit, unsigned char* l) {
    const int jc = unit % NCH, r0 = unit / NCH, dir = r0 & 1, h = (r0 >> 1) & 3, mixer = r0 >> 3;
    const u16* PROJ = (const u16*)(p.ws + OFF_BIG + BO_PROJ);
    u16* GST = (u16*)(p.ws + OFF_BIG + BO_GST); float* GDEC = (float*)(p.ws + OFF_GDEC);
    const float* lbv = (const float*)(p.ws + OFF_LB) + lbj * 512;
    const int tid = tidx(), t = tid >> 3, d0 = (tid & 7) * 16, rowbase = gla_rowbase(b, jc);
    const int n = scan_idx(jc, dir);
    const size_t seq = (size_t)((mixer * 4 + h) * 2 + dir) * NCH + n;
    __syncthreads();
    float kv[16];
    gla_cum(l, PROJ, lbv, mixer, h, dir, rowbase, kv);
    gla_load_vt(l, PROJ, mixer, h, rowbase);
    const float* cum = (const float*)(l + GL_CUM); u16* kdt = (u16*)(l + GL_KDT);
    const int te = dir ? 0 : 63;
#pragma unroll
    for (int i = 0; i < 16; ++i) { const float e = cum[te * 128 + d0 + i]; kdt[(d0 + i) * GL_S72 + t] = f2bf(kv[i] * __expf(e - cum[t * 128 + d0 + i])); }
    if (tid < 128) GDEC[seq * 128 + tid] = __expf(cum[te * 128 + tid]);
    __syncthreads();
    const int w = tid >> 6, lane = tid & 63, l31 = lane & 31, hh = lane >> 5, er = w >> 1;
    const u16* vt = (const u16*)(l + GL_VT);
#pragma unroll
    for (int q = 0; q < 2; ++q) {
        const int dc = (w & 1) * 2 + q;
        f32x16 a;
#pragma unroll
        for (int i = 0; i < 16; ++i) a[i] = 0.f;
#pragma unroll
        for (int ks = 0; ks < 4; ++ks) {
            const bf16x8 af = *(const bf16x8*)(vt + (32 * er + l31) * GL_S72 + 16 * ks + 8 * hh);
            const bf16x8 bf = *(const bf16x8*)(kdt + (32 * dc + l31) * GL_S72 + 16 * ks + 8 * hh);
            a = MFMA32(af, bf, a);
        }
        u16* dst = GST + seq * 16384;
#pragma unroll
        for (int i = 0; i < 16; ++i) dst[(32 * er + crow32(i, hh)) * 128 + 32 * dc + l31] = f2bf(a[i]);
    }
}
DI void gla_scan(const Params& p) {
    u16* GST = (u16*)(p.ws + OFF_BIG + BO_GST); const float* GDEC = (const float*)(p.ws + OFF_GDEC);
    for (int gt = blockIdx.x * 512 + tidx(); gt < 16 * 8192; gt += gridDim.x * 512) {
    const int sq = gt >> 13, idx = (gt & 8191) * 2, d = idx & 127;
    unsigned* base = (unsigned*)(GST + (size_t)sq * NCH * 16384 + idx); const float* dec = GDEC + (size_t)sq * NCH * 128 + d;
    float s0 = 0.f, s1 = 0.f; asm volatile("" : "+v"(s0), "+v"(s1));
    for (int n0 = 0; n0 < NCH; n0 += 12) {
        unsigned kv[12]; float2 dc[12];
#pragma unroll
        for (int i = 0; i < 12; ++i) { kv[i] = base[(size_t)(n0 + i) * 8192]; dc[i] = *(const float2*)(dec + (size_t)(n0 + i) * 128); }
#pragma unroll
        for (int i = 0; i < 12; ++i) { base[(size_t)(n0 + i) * 8192] = pk2(s0, s1);
            s0 = dc[i].x * s0 + bflo(kv[i]); s1 = dc[i].y * s1 + bfhi(kv[i]); }
    }
    }
}
DI void gla_pass3_unit(const Params& p, int b, int lbj, int jodd, int unit, unsigned char* l) {
    const int jc = unit % NCH, r0 = unit / NCH, h = r0 & 3, mixer = r0 >> 2;
    const u16* PROJ = (const u16*)(p.ws + OFF_BIG + BO_PROJ);
    const u16* GST = (const u16*)(p.ws + OFF_BIG + BO_GST);
    const float* lbv = (const float*)(p.ws + OFF_LB) + lbj * 512;
    u16* HB = (u16*)(p.ws + OFF_HB);
    const int tid = tidx(), t = tid >> 3, d0 = (tid & 7) * 16, rowbase = gla_rowbase(b, jc);
    const int w = tid >> 6, lane = tid & 63, l31 = lane & 31, hh = lane >> 5, tr = w >> 2, ec = w & 3;
    f32x16 oacc;
#pragma unroll
    for (int i = 0; i < 16; ++i) oacc[i] = 0.f;
    __syncthreads();
    gla_load_vt(l, PROJ, mixer, h, rowbase);
    float qv[16]; ld16(PROJ + (size_t)(rowbase + t) * 4608 + (mixer ? 2048 : 0) + h * 128 + d0, qv);
    for (int dir = 0; dir < 2; ++dir) {
        float kv[16];
        bf16x8 sfr[8];
        { const u16* S = GST + ((size_t)((mixer * 4 + h) * 2 + dir) * NCH + scan_idx(jc, dir)) * 16384 + (32 * ec + l31) * 128 + 8 * hh;
#pragma unroll
          for (int ks = 0; ks < 8; ++ks) sfr[ks] = *(const bf16x8*)(S + 16 * ks); }
        gla_cum(l, PROJ, lbv, mixer, h, dir, rowbase, kv);
        const float* cum = (const float*)(l + GL_CUM);
        u16* qt = (u16*)(l + GL_QT); u16* ktl = (u16*)(l + GL_KT); u16* qsl = (u16*)(l + GL_QS); u16* att = (u16*)(l + GL_ATT);
        const int tref = dir ? 32 : 31;
        {
            float fq_[16], fk_[16], fs_[16];
#pragma unroll
            for (int i = 0; i < 16; ++i) { const float c = cum[t * 128 + d0 + i], rf = cum[tref * 128 + d0 + i];
                fq_[i] = qv[i] * __expf(c - rf); fk_[i] = kv[i] * __expf(rf - c); fs_[i] = qv[i] * __expf(c); }
#pragma unroll
            for (int hf = 0; hf < 2; ++hf) { u32x4 wq, wk, ws;
                wq.x = pk2(fq_[8 * hf], fq_[8 * hf + 1]); wq.y = pk2(fq_[8 * hf + 2], fq_[8 * hf + 3]); wq.z = pk2(fq_[8 * hf + 4], fq_[8 * hf + 5]); wq.w = pk2(fq_[8 * hf + 6], fq_[8 * hf + 7]);
                wk.x = pk2(fk_[8 * hf], fk_[8 * hf + 1]); wk.y = pk2(fk_[8 * hf + 2], fk_[8 * hf + 3]); wk.z = pk2(fk_[8 * hf + 4], fk_[8 * hf + 5]); wk.w = pk2(fk_[8 * hf + 6], fk_[8 * hf + 7]);
                ws.x = pk2(fs_[8 * hf], fs_[8 * hf + 1]); ws.y = pk2(fs_[8 * hf + 2], fs_[8 * hf + 3]); ws.z = pk2(fs_[8 * hf + 4], fs_[8 * hf + 5]); ws.w = pk2(fs_[8 * hf + 6], fs_[8 * hf + 7]);
                *(u32x4*)(qt + t * GL_S136 + d0 + 8 * hf) = wq; *(u32x4*)(ktl + t * GL_S136 + d0 + 8 * hf) = wk; *(u32x4*)(qsl + t * GL_S136 + d0 + 8 * hf) = ws; }
        }
        __syncthreads();
        { const int tt = w >> 1;
#pragma unroll
          for (int q = 0; q < 2; ++q) { const int ts = (w & 1) * 2 + q;
            f32x4 a = (f32x4){0.f, 0.f, 0.f, 0.f};
#pragma unroll
            for (int ks = 0; ks < 4; ++ks) {
                const bf16x8 af = *(const bf16x8*)(qt + (16 * tt + (lane & 15)) * GL_S136 + 32 * ks + 8 * (lane >> 4));
                const bf16x8 bf = *(const bf16x8*)(ktl + (16 * ts + (lane & 15)) * GL_S136 + 32 * ks + 8 * (lane >> 4));
                a = MFMA16(af, bf, a); }
#pragma unroll
            for (int i = 0; i < 4; ++i) { const int trow = 16 * tt + 4 * (lane >> 4) + i, scol = 16 * ts + (lane & 15);
                const bool keep = dir ? (scol >= trow) : (scol <= trow);
                att[trow * GL_S72 + scol] = f2bf(keep ? a[i] : 0.f); } } }
        __syncthreads();
        const u16* vt = (const u16*)(l + GL_VT);
#pragma unroll
        for (int ks = 0; ks < 4; ++ks) {
            const bf16x8 af = *(const bf16x8*)(att + (32 * tr + l31) * GL_S72 + 16 * ks + 8 * hh);
            const bf16x8 bf = *(const bf16x8*)(vt + (32 * ec + l31) * GL_S72 + 16 * ks + 8 * hh);
            oacc = MFMA32(af, bf, oacc); }
#pragma unroll
        for (int ks = 0; ks < 8; ++ks) {
            const bf16x8 af = *(const bf16x8*)(qsl + (32 * tr + l31) * GL_S136 + 16 * ks + 8 * hh);
            oacc = MFMA32(af, sfr[ks], oacc); }
        __syncthreads();
    }
    float* ob = (float*)(l + GL_CUM);
#pragma unroll
    for (int i = 0; i < 16; ++i) ob[(32 * tr + crow32(i, hh)) * 132 + 32 * ec + l31] = oacc[i];
    __syncthreads();
    { float v[16]; float s = 0.f;
#pragma unroll
      for (int i = 0; i < 16; ++i) { v[i] = ob[t * 132 + d0 + i]; s += v[i]; }
      if (mixer == 0) { s += __shfl_xor(s, 1); s += __shfl_xor(s, 2); s += __shfl_xor(s, 4); const float mean = s * (1.f / 128.f);
#pragma unroll
          for (int i = 0; i < 16; ++i) v[i] -= mean; }
      float ss = 0.f;
#pragma unroll
      for (int i = 0; i < 16; ++i) ss += v[i] * v[i];
      ss += __shfl_xor(ss, 1); ss += __shfl_xor(ss, 2); ss += __shfl_xor(ss, 4);
      const float rstd = rsqrtf(ss * (1.f / 128.f) + EPS);
      const float* gn = (mixer ? p.in[30] : p.in[28]) + jodd * 512 + h * 128 + d0;
      float gt_[16]; ld16(PROJ + (size_t)(rowbase + t) * 4608 + (mixer ? 4096 : 1536) + h * 128 + d0, gt_);
      u32x4 o0, o1; float r[16];
#pragma unroll
      for (int i = 0; i < 16; ++i) r[i] = v[i] * rstd * gn[i] * siluf_(gt_[i]);
      o0.x = pk2(r[0], r[1]); o0.y = pk2(r[2], r[3]); o0.z = pk2(r[4], r[5]); o0.w = pk2(r[6], r[7]);
      o1.x = pk2(r[8], r[9]); o1.y = pk2(r[10], r[11]); o1.z = pk2(r[12], r[13]); o1.w = pk2(r[14], r[15]);
      u16* dst = HB + (size_t)(rowbase + t) * 1024 + mixer * 512 + h * 128 + d0;
      *(u32x4*)dst = o0; *(u32x4*)(dst + 8) = o1; }
}

#define XB_TMO      128
#define XB_XCNT(j)  (256  + 64 * (j))
#define XB_XSUB(j)  (1280 + 64 * (j))
#define XB_XGEN(j)  (2304 + 64 * (j))
#define XB_TOP      3328
#define XB_TOPGEN   3392
#define XCD_BAR_WORDS 3456
#define XB_SPIN_CAP (1u << 22)
DI unsigned xb_ld(unsigned* p)              { return __hip_atomic_load(p, __ATOMIC_RELAXED, __HIP_MEMORY_SCOPE_AGENT); }
DI unsigned xb_add(unsigned* p, unsigned v) { return __hip_atomic_fetch_add(p, v, __ATOMIC_RELAXED, __HIP_MEMORY_SCOPE_AGENT); }
DI unsigned xb_xcc_id() { return (unsigned)__builtin_amdgcn_s_getreg((3 << 11) | 20) & 0xFu; }
#define XB_SPIN(cond, bar) do { unsigned _sp = 0; while (cond) { __builtin_amdgcn_s_sleep(1); \
    if ((++_sp & 255u) == 0u) { if (xb_ld(&(bar)[XB_TMO])) break; if (_sp > XB_SPIN_CAP) { atomicAdd(&(bar)[XB_TMO], 1u); break; } } } } while (0)
struct XcdBarrier { unsigned* bar; unsigned x; volatile LAS unsigned* st; };
DI XcdBarrier xcd_barrier_post(unsigned* bar, volatile LAS unsigned* st) {
    XcdBarrier b; b.bar = bar; b.x = xb_xcc_id(); b.st = st;
    if (threadIdx.x == 0) (void)xb_add(&bar[XB_XCNT(b.x)], 1u);
    return b;
}
DI void xcd_barrier_complete(unsigned* bar, unsigned x, unsigned& nloc, unsigned& nx) {
    const unsigned G = gridDim.x * gridDim.y * gridDim.z;
    unsigned sum, cnt, mine, sp = 0u;
    for (;;) {
        sum = 0u; cnt = 0u; mine = 0u;
#pragma unroll
        for (unsigned j = 0; j < 16; ++j) { const unsigned c = xb_ld(&bar[XB_XCNT(j)]); sum += c; cnt += (c > 0u) ? 1u : 0u; mine = (j == x) ? c : mine; }
        if (sum == G) break;
        __builtin_amdgcn_s_sleep(1);
        if ((++sp & 255u) == 0u) { if (xb_ld(&bar[XB_TMO])) break; if (sp > XB_SPIN_CAP) { atomicAdd(&bar[XB_TMO], 1u); break; } }
    }
    nloc = mine > 0u ? mine : 1u; nx = cnt > 0u ? cnt : 1u;
}
DI void xcd_barrier(const XcdBarrier& b) {
    asm volatile("s_waitcnt vmcnt(0)" ::: "memory");
    __syncthreads();
    if (threadIdx.x == 0) {
        unsigned* bar = b.bar;
        __builtin_amdgcn_s_waitcnt(0);
        unsigned nloc = b.st[0], nx = b.st[1];
        if (nloc == 0u) { xcd_barrier_complete(bar, b.x, nloc, nx); b.st[0] = nloc; b.st[1] = nx; }
        const unsigned old = xb_add(&bar[XB_XSUB(b.x)], 1u);
        const unsigned gen = old / nloc;
        if (old + 1u == (gen + 1u) * nloc) {
            __builtin_amdgcn_fence(__ATOMIC_RELEASE, "agent");
            asm volatile("s_waitcnt vmcnt(0)" ::: "memory");
            const unsigned og = xb_add(&bar[XB_TOP], 1u);
            const unsigned tg = og / nx;
            if (og + 1u == (tg + 1u) * nx) xb_add(&bar[XB_TOPGEN], 1u);
            else XB_SPIN(xb_ld(&bar[XB_TOPGEN]) == tg, bar);
            __builtin_amdgcn_fence(__ATOMIC_ACQUIRE, "agent");
            xb_add(&bar[XB_XGEN(b.x)], 1u);
            asm volatile("s_waitcnt vmcnt(0)" ::: "memory");
        } else {
            XB_SPIN(xb_ld(&bar[XB_XGEN(b.x)]) == gen, bar);
            __builtin_amdgcn_fence(__ATOMIC_ACQUIRE, "agent");
            asm volatile("s_waitcnt vmcnt(0)" ::: "memory");
        }
    }
    __syncthreads();
}

__global__ void __launch_bounds__(512) fwd_megakernel(Params p0) {
    Params p = p0;
    extern __shared__ __attribute__((aligned(16))) unsigned char lds_raw[];
    LAS unsigned char* lds = (LAS unsigned char*)lds_raw;
    cg::grid_group grid = cg::this_grid();
    volatile LAS unsigned* xst = (volatile LAS unsigned*)(lds + 147440);
    if (threadIdx.x < 4) xst[threadIdx.x] = 0u;
    __syncthreads();
    const XcdBarrier xb = xcd_barrier_post((unsigned*)(p.ws + OFF_BAR), xst);
#define GSYNC() do { for (int r_ = 0; r_ < REP(1); ++r_) xcd_barrier(xb); } while (0)
    unsigned char* ws = p.ws;
    float* mod = (float*)(ws + OFF_MOD);
    float* XRES = (float*)(ws + OFF_XRES);
    u16* HB = (u16*)(ws + OFF_HB);
    unsigned char* BIG = ws + OFF_BIG;
    const int G = gridDim.x, bid = blockIdx.x;

    for (int r_ = 0; r_ < REP(32); ++r_) prep_phase(p, (float*)lds_raw);
    if (p.ws == nullptr) grid.sync();
    GSYNC();
    { const float* mp = (const float*)(p.ws + OFF_MODP); float* md = (float*)(p.ws + OFF_MOD);
      for (int i = bid * 512 + tidx(); i < 4 * 3 * 6144; i += G * 512) { float a = 0.f;
#pragma unroll
        for (int k = 0; k < 16; ++k) a += mp[(size_t)k * (4 * 3 * 6144) + i];
        md[i] = a; } }
    GSYNC();

    for (int li = 0; li < 4; ++li) {
        asm volatile("" : "+s"(p.ws));
        ws = p.ws; mod = (float*)(ws + OFF_MOD); XRES = (float*)(ws + OFF_XRES); HB = (u16*)(ws + OFF_HB); BIG = ws + OFF_BIG;
        const float* srcLat = li == 0 ? p.in[0] : XRES;
        const float* srcCtx = li == 0 ? p.in[2] : XRES + (size_t)NLAT * 1024;
        const float* modl = mod + li * 3 * 6144;
        const int j = li >> 1;
        for (int r_ = 0; r_ < REP(16); ++r_) { norm_rows(srcLat, srcCtx, p.in[6] + li * 1024, modl, 1024, 0, HB, li > 0 ? (float*)(BIG + 150000000) : nullptr, 11, mod + (li - 1) * 3 * 6144 + 2 * 6144 + 5 * 1024, XRES);
        conv_ffn_weights(p, li, (float*)lds_raw); }
        GSYNC();
        if ((li & 1) == 0) {
            float* ssq = (float*)(ws + OFF_SSQ); float* sskv = ssq + (size_t)NTOK * 8;
            u16* U = (u16*)(BIG + BE_U); u16* CQKV = (u16*)(BIG + BE_CQKV); u16* Q = (u16*)(BIG + BE_Q); u16* KC = (u16*)(BIG + BE_KC); u16* VT = (u16*)(BIG + BE_VT); u16* Z = (u16*)(BIG + BE_Z);
            { EpiInEven E{U, CQKV, KC, ssq, sskv, (const float*)(ws + OFF_RMLA)};
              run_gemm(lds, HB, 1024, (const u16*)(ws + OFF_WMIX + WE_IN), 1024, NTOK, 1024, 1024, E);
              if (REP(2) > 1) { EpiInEven E2{U, CQKV, KC, (float*)(BIG + 150000000), (float*)(BIG + 150000000), (const float*)(ws + OFF_RMLA)}; run_gemm(lds, HB, 1024, (const u16*)(ws + OFF_WMIX + WE_IN), 1024, NTOK, 1024, 1024, E2); } }
            GSYNC();
            for (int r_ = 0; r_ < REP(8); ++r_) for (int u = bid; u < 2 * NCH * 4; u += G) s5_pass1_unit(p, j, u, lds_raw);
            GSYNC();
            s5_carry_scan(p, j, G > 16 ? G - 16 : 0);
            { EpiQ E{Q, ssq, (const float*)(ws + OFF_RMLA)};
              for (int r_ = 0; r_ < REP(2); ++r_) run_gemm(lds, CQKV, 384, (const u16*)(ws + OFF_WMIX + WE_UQ), 256, NTOK, 768, 256, E); }
            { EpiKV E{KC, VT, sskv};
              for (int r_ = 0; r_ < REP(2); ++r_) run_gemm(lds, CQKV + 128, 384, (const u16*)(ws + OFF_WMIX + WE_UKV), 256, NTOK, 1024, 256, E); }
            GSYNC();
            for (int r_ = 0; r_ < 2; ++r_) for (int u = bid; u < 272 + 1056; u += G) {
                if (r_ == 1 && !(u < 272 ? REP(4) > 1 : REP(8) > 1)) continue;
                if (u < 256) { const int bh = (u & 7) * 2 + (u >> 7), qb = (u >> 3) & 15;
                    __syncthreads();
                    attn_unit64(lds, Q + ((size_t)bh * SEQ + qb * 512) * 96, KC + (size_t)bh * LK * 96, VT + (size_t)bh * 64 * LK, LK / 64,
                                HB + (size_t)((bh >> 3) * SEQ + qb * 512) * 1024 + 512 + (bh & 7) * 64);
                } else if (u < 272) { const int bh = u - 256;
                    __syncthreads();
                    attn_unit(lds, Q + (size_t)NLAT * 768 + (size_t)bh * CTXL * 96, KC + (size_t)bh * LK * 96, VT + (size_t)bh * 64 * LK, CTXL / 64,
                              HB + (size_t)(NLAT + (bh >> 3) * CTXL) * 1024 + 512 + (bh & 7) * 64);
                } else s5_pass2_unit(p, j, u - 272, lds_raw);
            }
            GSYNC();
            { EpiGlu E{Z, HB};
              for (int r_ = 0; r_ < REP(2); ++r_) run_gemm(lds, Z, 512, (const u16*)(ws + OFF_WMIX + WE_GLU), 512, NTOK, 512, 512, E); }
            GSYNC();
            { EpiRes E{srcLat, srcCtx, modl + 2048, XRES, (float*)(BIG + 150000000)};
              run_gemm_mixed(lds, HB, 1024, (const u16*)(ws + OFF_WMIX + WE_OUT), 1024, 1024, 1024, E);
              if (REP(2) > 1) { EpiRes E2{srcLat, srcCtx, modl + 2048, (float*)(BIG + 150000000), (float*)(BIG + 150000000)}; run_gemm(lds, HB, 1024, (const u16*)(ws + OFF_WMIX + WE_OUT), 1024, NTOK, 1024, 1024, E2); } }
            GSYNC();
        } else {
            u16* PROJ = (u16*)(BIG + BO_PROJ);
            { EpiInOdd E{PROJ, (const float*)(ws + OFF_RRET)};
              for (int r_ = 0; r_ < REP(2); ++r_) run_gemm(lds, HB, 1024, (const u16*)(ws + OFF_WMIX + WO_IN), 1024, NTOK, 4608, 1024, E); }
            GSYNC();
            for (int b = 0; b < 2; ++b) {
                for (int r_ = 0; r_ < REP(64); ++r_) for (int u = bid; u < 16 * NCH; u += G) gla_pass1_unit(p, b, j, u, lds_raw);
                GSYNC();
                gla_scan(p);
                GSYNC();
                for (int r_ = 0; r_ < REP(128); ++r_) for (int u = bid; u < 8 * NCH; u += G) gla_pass3_unit(p, b, j, j, u, lds_raw);
                GSYNC();
            }
            { EpiRes E{srcLat, srcCtx, modl + 2048, XRES, (float*)(BIG + 150000000)};
              { if (li == 3) run_gemm(lds, HB, 1024, (const u16*)(ws + OFF_WMIX + WO_OUT), 1024, NLAT, 1024, 1024, E); else run_gemm_mixed(lds, HB, 1024, (const u16*)(ws + OFF_WMIX + WO_OUT), 1024, 1024, 1024, E); }
              if (REP(2) > 1) { EpiRes E2{srcLat, srcCtx, modl + 2048, (float*)(BIG + 150000000), (float*)(BIG + 150000000)}; run_gemm(lds, HB, 1024, (const u16*)(ws + OFF_WMIX + WO_OUT), 1024, NTOK, 1024, 1024, E2); } }
            GSYNC();
        }
        for (int r_ = 0; r_ < REP(16); ++r_) { norm_rows(XRES, srcCtx, p.in[7] + li * 1024, modl, 4 * 1024, 3 * 1024, HB, li < 3 ? (float*)(BIG + 150000000) : nullptr, 4, modl + 2 * 6144 + 2048, XRES);
        if (li < 3) conv_mixer_weights(p, li + 1, (float*)lds_raw); }
        GSYNC();
        { EpiFFN1 E{(u16*)(BIG)};
          for (int r_ = 0; r_ < REP(2); ++r_) { if (li == 3) run_gemm(lds, HB, 1024, (const u16*)(ws + OFF_WFFN + WF_13), 1024, NLAT, 5632, 1024, E); else run_gemm(lds, HB, 1024, (const u16*)(ws + OFF_WFFN + WF_13), 1024, NTOK, 5632, 1024, E); } }
        GSYNC();
        { EpiRes E{XRES, XRES + (size_t)NLAT * 1024, modl + 5 * 1024, XRES, (float*)(BIG + 150000000)};
          { if (li == 3) run_gemm(lds, (const u16*)BIG, DFF, (const u16*)(ws + OFF_WFFN + WF_2), DFF, NLAT, 1024, DFF, E); else run_gemm_mixed(lds, (const u16*)BIG, DFF, (const u16*)(ws + OFF_WFFN + WF_2), DFF, 1024, DFF, E); }
          if (REP(2) > 1) { EpiRes E2{XRES, XRES + (size_t)NLAT * 1024, modl + 5 * 1024, (float*)(BIG + 150000000), (float*)(BIG + 150000000)}; run_gemm(lds, (const u16*)BIG, DFF, (const u16*)(ws + OFF_WFFN + WF_2), DFF, NTOK, 1024, DFF, E2); } }
        GSYNC();
    }
    final_norm_rows(XRES, p.in[31], p.out);
}

extern "C" void kernel_launch(void* const* d_in, const int* in_sizes, int n_in, void* d_out, int out_size,
                              void* d_ws, size_t ws_size, hipStream_t stream) {
    constexpr size_t kDynLds = 147456;
    static int grid_blocks = 0;
    if (!grid_blocks) {
        int dev = 0, cus = 0, per_cu = 0;
        (void)hipGetDevice(&dev);
        (void)hipDeviceGetAttribute(&cus, hipDeviceAttributeMultiprocessorCount, dev);
        (void)hipFuncSetAttribute((const void*)fwd_megakernel, hipFuncAttributeMaxDynamicSharedMemorySize, (int)kDynLds);
        (void)hipOccupancyMaxActiveBlocksPerMultiprocessor(&per_cu, fwd_megakernel, 512, kDynLds);
        if (per_cu > 1) per_cu = 1;
        grid_blocks = cus * per_cu;
        if (ws_size < WS_NEED) fprintf(stderr, "workspace too small: %zu < %zu\n", ws_size, (size_t)WS_NEED);
    }
    Params p{};
    for (int i = 0; i < 32; ++i) p.in[i] = (const float*)d_in[i];
    p.out = (float*)d_out; p.ws = (unsigned char*)d_ws;
    (void)hipMemsetAsync((unsigned char*)d_ws + OFF_BAR, 0, 16384, stream);
    void* args[] = {&p};
    hipError_t e = hipLaunchCooperativeKernel((void*)fwd_megakernel, dim3(grid_blocks), dim3(512), args, kDynLds, stream);
    if (e != hipSuccess) fprintf(stderr, "cooperative launch failed: %s (grid %d)\n", hipGetErrorString(e), grid_blocks);
}
```

```cpp
#include <hip/hip_runtime.h>
#include <hip/hip_cooperative_groups.h>
#include <cstdio>
namespace cg = cooperative_groups;
#ifndef PROBE
#define PROBE 0
#endif
#define REP(mask) ((PROBE & (mask)) ? 2 : 1)
#define DI __device__ __forceinline__
#define LAS __attribute__((address_space(3)))
typedef unsigned short u16;
typedef short bf16x8 __attribute__((ext_vector_type(8)));
typedef float f32x4 __attribute__((ext_vector_type(4)));
typedef float f32x16 __attribute__((ext_vector_type(16)));
typedef unsigned u32x4 __attribute__((ext_vector_type(4)));
typedef unsigned u32x2 __attribute__((ext_vector_type(2)));

constexpr int DM = 1024, SEQ = 8192, CTXL = 256, NLAT = 16384, NCTX = 512, NTOK = 16896, DFF = 2816, LK = 8448;
constexpr int NCH = 132;
constexpr float EPS = 1e-6f;

constexpr size_t al256(size_t x) { return (x + 255) & ~(size_t)255; }
constexpr size_t OFF_MOD = 0;
constexpr size_t OFF_RMLA = al256(OFF_MOD + 4 * 3 * 6144 * 4);
constexpr size_t OFF_RRET = al256(OFF_RMLA + 8192 * 16 * 2 * 4);
constexpr size_t OFF_LB = al256(OFF_RRET + 8192 * 64 * 2 * 4);
constexpr size_t OFF_SAB = al256(OFF_LB + 2 * 512 * 4);
constexpr size_t OFF_SA64 = al256(OFF_SAB + 2 * 2 * 2048 * 8);
constexpr size_t OFF_SBB = al256(OFF_SA64 + 2 * 2 * 2048 * 8);
constexpr size_t OFF_SCC = al256(OFF_SBB + 2 * 2 * 2048 * 16 * 8);
constexpr size_t OFF_SSQ = al256(OFF_SCC + 2 * 2 * 32 * 16 * 128 * 2);
constexpr size_t OFF_GDEC = al256(OFF_SSQ + (size_t)NTOK * 12 * 4);
constexpr size_t OFF_WMIX = al256(OFF_GDEC + 2 * 4 * 2 * NCH * 128 * 4);
constexpr size_t WMIX_BYTES = 9437184 + 2097152;
constexpr size_t OFF_WFFN = al256(OFF_WMIX + WMIX_BYTES);
constexpr size_t WFFN_BYTES = (size_t)5632 * 1024 * 2 + (size_t)1024 * 2816 * 2;
constexpr size_t OFF_XRES = al256(OFF_WFFN + WFFN_BYTES);
constexpr size_t OFF_HB = al256(OFF_XRES + (size_t)NTOK * 1024 * 4);
constexpr size_t OFF_BIG = al256(OFF_HB + (size_t)NTOK * 1024 * 2);
constexpr size_t BE_U = 0;
constexpr size_t BE_CQKV = al256(BE_U + (size_t)NTOK * 512 * 2);
constexpr size_t BE_Q = al256(BE_CQKV + (size_t)NTOK * 384 * 2);
constexpr size_t BE_KC = al256(BE_Q + (size_t)NTOK * 768 * 2);
constexpr size_t BE_VT = al256(BE_KC + (size_t)2 * 8 * LK * 96 * 2);
constexpr size_t BE_Z = al256(BE_VT + (size_t)2 * 8 * 64 * LK * 2);
constexpr size_t BE_S5E = al256(BE_Z + (size_t)NTOK * 512 * 2);
constexpr size_t BO_PROJ = 0;
constexpr size_t BO_GST = al256(BO_PROJ + (size_t)NTOK * 4608 * 2);
constexpr size_t BIG_BYTES = BO_GST + (size_t)2 * 4 * 2 * NCH * 16384 * 2;
constexpr size_t OFF_BAR = al256(OFF_BIG + BIG_BYTES);
constexpr size_t OFF_MODP = OFF_BAR + 16384;
constexpr size_t WS_NEED = OFF_MODP + (size_t)16 * 4 * 3 * 6144 * 4;
constexpr size_t WE_IN = 0, WE_OUT = 2097152, WE_GLU = 4194304, WE_UQ = 4718592, WE_UKV = 5242880;
constexpr size_t WO_IN = 0, WO_OUT = 9437184;
constexpr size_t WF_13 = 0, WF_2 = (size_t)5632 * 1024 * 2;

struct Params { const float* in[32]; float* out; unsigned char* ws; };

DI int tidx() { int t = threadIdx.x; asm volatile("" : "+v"(t)); return t; }
typedef float f32x2 __attribute__((ext_vector_type(2)));
typedef __bf16 bf16x2_t __attribute__((ext_vector_type(2)));
DI unsigned pk2(float lo, float hi) { const f32x2 v = {lo, hi}; const bf16x2_t b = __builtin_convertvector(v, bf16x2_t); return __builtin_bit_cast(unsigned, b); }
DI u16 f2bf(float x) { return (u16)(pk2(x, x) & 0xffffu); }
DI float bf2f(u16 b) { return __uint_as_float(((unsigned)b) << 16); }
DI float bflo(unsigned w) { return __uint_as_float(w << 16); }
DI float bfhi(unsigned w) { return __uint_as_float(w & 0xffff0000u); }
DI float sigmoidf_(float x) { return 1.f / (1.f + __expf(-x)); }
DI float siluf_(float x) { return x / (1.f + __expf(-x)); }
DI float gelu_tanh(float y) { float t = 0.7978845608028654f * (y + 0.044715f * y * y * y); return 0.5f * y * (1.f + tanhf(t)); }
DI int tok_b(int row) { return row < NLAT ? (row >> 13) : ((row - NLAT) >> 8); }
DI int tok_bidx(int row) { return row < NLAT ? (row >> 13) : 2; }
#define MFMA32(a, b, c) __builtin_amdgcn_mfma_f32_32x32x16_bf16((a), (b), (c), 0, 0, 0)
#define MFMA16(a, b, c) __builtin_amdgcn_mfma_f32_16x16x32_bf16((a), (b), (c), 0, 0, 0)
DI int scan_idx(int jc, int dir) { return dir ? (jc < 4 ? 3 - jc : 135 - jc) : jc; }
DI int crow32(int i, int hh) { return (i & 3) + 8 * (i >> 2) + 4 * hh; }

namespace pg8 {
constexpr int BM = 256, BK = 64, HALF = 128, HTB = HALF * BK * 2, NXCD = 8, WGM = 8;
DI int lds_byte(int r, int c) { const int st = (r >> 4) * 2 + (c >> 5), rr = r & 15, cc = c & 31, ob = rr * 64 + cc * 2; return st * 1024 + (ob ^ (((ob >> 9) & 1) << 5)); }
DI void stage_rc(int b, int& R, int& C) { const int st = b / 1024, sb = b % 1024, swz = sb ^ (((sb >> 9) & 1) << 5); R = (st >> 1) * 16 + swz / 64; C = (st & 1) * 32 + (swz % 64) / 2; }
struct Unit { int pm, pn, ks; };
struct Gemm { const u16* A; const u16* Bt; int M, N, K, lda, ldb; };
struct StaticOrder {
    int nM, nN, nwg, G, c;
    DI void init(int M, int N, int G_, int c_) { nM = M / BM; nN = N / BM; nwg = nM * nN; G = G_; c = c_; }
    DI bool next(int i, Unit& u) const {
        const long L = (long)i * G + c; if (L >= nwg) return false;
        int wgid = (int)L; { const int q = nwg / NXCD, r = nwg % NXCD, xcd = wgid % NXCD, off = wgid / NXCD; wgid = (xcd < r ? xcd * (q + 1) : r * (q + 1) + (xcd - r) * q) + off; }
        const int nig = WGM * nN, gid = wgid / nig, fm = gid * WGM, gsz = (nM - fm) < WGM ? (nM - fm) : WGM;
        u.pm = fm + ((wgid % nig) % gsz); u.pn = (wgid % nig) / gsz; u.ks = -1; return true;
    }
};
struct MixedOrder {
    StaticOrder lat; int nN, KS, nlat, ntot;
    DI void init(int N, int KS_, int G_, int c_) { lat.init(16384, N, G_, c_); nN = N / BM; KS = KS_; nlat = lat.nwg; ntot = nlat + 2 * nN * KS; }
    DI bool next(int i, Unit& u) const {
        const long L = (long)i * lat.G + lat.c; if (L >= ntot) return false;
        if (L < nlat) return lat.next(i, u);
        const int e = (int)L - nlat, r = e / KS; u.ks = e - r * KS; u.pn = r % nN; u.pm = 64 + r / nN; return true;
    }
};
template <class Epi, class Sched>
DI void gemm_phase(LAS unsigned char* lds, const Gemm g, const Sched& S, const Epi& E) {
    const int tid = tidx(), wid = __builtin_amdgcn_readfirstlane(tid >> 6), lane = tid & 63, wr = wid >> 2, wc = wid & 3, fr = lane & 15, fq = lane >> 4;
    int K = g.K; asm volatile("" : "+s"(K)); const int ntFull = K / BK;
    unsigned voffA[2], voffB[2];
#pragma unroll
    for (int i = 0; i < 2; ++i) { int R, C; stage_rc(tid * 16 + i * 8192, R, C);
        voffA[i] = (unsigned)(R * g.lda + C) * 2u; voffB[i] = (unsigned)(R * g.ldb + C) * 2u; }
    const size_t kstep = (size_t)(BK * 2);
    const size_t hstepA = (size_t)HALF * g.lda * 2, hstepB = (size_t)HALF * g.ldb * 2;
    const size_t tstepA = 2 * hstepA, tstepB = 2 * hstepB;
    const unsigned ldsw = (unsigned)wid * 1024u;
    const int aoff = lds_byte(wr * 64 + fr, fq * 8), boff = lds_byte(wc * 32 + fr, fq * 8);
#define PG8_SA(b, h) (((b) * 2 + (h)) * HTB)
#define PG8_SB(b, h) ((4 + (b) * 2 + (h)) * HTB)
#define PG8_STAGE(bufoff, gbase, voff) do { _Pragma("unroll") for (int _i = 0; _i < 2; ++_i) \
        __builtin_amdgcn_global_load_lds((const unsigned*)((const char*)(gbase) + (voff)[_i]), (LAS unsigned*)(lds + (bufoff) + ldsw + _i * 8192), 16, 0, 0); } while (0)
#define PG8_LDA(dst, b, h) do { _Pragma("unroll") for (int m = 0; m < 4; ++m) _Pragma("unroll") for (int k = 0; k < 2; ++k) dst[m][k] = *(const LAS bf16x8*)(lds + PG8_SA(b, h) + aoff + m * 2048 + k * 1024); } while (0)
#define PG8_LDB(dst, b, h) do { _Pragma("unroll") for (int n = 0; n < 2; ++n) _Pragma("unroll") for (int k = 0; k < 2; ++k) dst[n][k] = *(const LAS bf16x8*)(lds + PG8_SB(b, h) + boff + n * 2048 + k * 1024); } while (0)
#define PG8_MMA(ai, bj, At, Bt) do { __builtin_amdgcn_s_setprio(1); _Pragma("unroll") for (int m = 0; m < 4; ++m) _Pragma("unroll") for (int n = 0; n < 2; ++n) _Pragma("unroll") for (int k = 0; k < 2; ++k) \
        acc[ai][bj][m][n] = __builtin_amdgcn_mfma_f32_16x16x32_bf16(Bt[n][k], At[m][k], acc[ai][bj][m][n], 0, 0, 0); __builtin_amdgcn_s_setprio(0); } while (0)
#define PG8_WAIT_V(n) asm volatile("s_waitcnt vmcnt(" #n ")" ::: "memory")
#define PG8_WAIT_L(n) asm volatile("s_waitcnt lgkmcnt(" #n ")" ::: "memory")
#define PG8_BAR __builtin_amdgcn_s_barrier()
#define PG8_SCHED __builtin_amdgcn_sched_barrier(0)
    Unit cur, nxt; int ui = 0;
    if (!S.next(0, cur)) return;
    f32x4 acc[2][2][4][2];
#pragma unroll
    for (int a = 0; a < 2; ++a)
#pragma unroll
        for (int b = 0; b < 2; ++b)
#pragma unroll
            for (int m = 0; m < 4; ++m)
#pragma unroll
                for (int n = 0; n < 2; ++n) acc[a][b][m][n] = (f32x4){0.f, 0.f, 0.f, 0.f};
    bf16x8 At[4][2], B0[2][2], B1[2][2];
    const char* cA = (const char*)g.A + (size_t)cur.pm * tstepA + (cur.ks >= 0 ? cur.ks * 512 : 0); const char* cB = (const char*)g.Bt + (size_t)cur.pn * tstepB + (cur.ks >= 0 ? cur.ks * 512 : 0);
    int nt = cur.ks >= 0 ? 4 : ntFull;
    PG8_STAGE(PG8_SB(0, 0), cB, voffB); PG8_STAGE(PG8_SA(0, 0), cA, voffA); PG8_STAGE(PG8_SB(0, 1), cB + hstepB, voffB); PG8_STAGE(PG8_SA(0, 1), cA + hstepA, voffA);
    if (wr == 1) PG8_BAR;
    PG8_WAIT_V(4); PG8_BAR;
    PG8_STAGE(PG8_SB(1, 0), cB + kstep, voffB); PG8_STAGE(PG8_SA(1, 0), cA + kstep, voffA); PG8_STAGE(PG8_SB(1, 1), cB + hstepB + kstep, voffB);
    PG8_WAIT_V(6); PG8_BAR;
    for (;;) {
        const bool has_next = S.next(ui + 1, nxt);
        const char* nA = has_next ? (const char*)g.A + (size_t)nxt.pm * tstepA + (nxt.ks >= 0 ? nxt.ks * 512 : 0) : cA; const char* nB = has_next ? (const char*)g.Bt + (size_t)nxt.pn * tstepB + (nxt.ks >= 0 ? nxt.ks * 512 : 0) : cB;
        for (int t = 0; t < nt; t += 2) {
            const bool last = (t == nt - 2);
            const char* a1 = cA + (size_t)(t + 1) * kstep;
            const char* a2 = last ? nA : cA + (size_t)(t + 2) * kstep; const char* b2 = last ? nB : cB + (size_t)(t + 2) * kstep;
            const char* a3 = a2 + kstep; const char* b3 = b2 + kstep;
            PG8_LDB(B0, 0, 0); PG8_SCHED; PG8_LDA(At, 0, 0); PG8_STAGE(PG8_SA(1, 1), a1 + hstepA, voffA);
            PG8_WAIT_L(8); PG8_BAR; PG8_WAIT_L(0); PG8_MMA(0, 0, At, B0); PG8_BAR; PG8_SCHED;
            PG8_LDB(B1, 0, 1); PG8_STAGE(PG8_SB(0, 0), b2, voffB);
            PG8_BAR; PG8_WAIT_L(0); PG8_MMA(0, 1, At, B1); PG8_BAR;
            PG8_LDA(At, 0, 1); PG8_STAGE(PG8_SA(0, 0), a2, voffA);
            PG8_BAR; PG8_WAIT_L(0); PG8_MMA(1, 0, At, B0); PG8_BAR; PG8_SCHED;
            PG8_STAGE(PG8_SB(0, 1), b2 + hstepB, voffB);
            PG8_WAIT_V(6); PG8_BAR; PG8_MMA(1, 1, At, B1); PG8_BAR;
            PG8_LDB(B0, 1, 0); PG8_SCHED; PG8_LDA(At, 1, 0); PG8_STAGE(PG8_SA(0, 1), a2 + hstepA, voffA);
            PG8_WAIT_L(8); PG8_BAR; PG8_WAIT_L(0); PG8_MMA(0, 0, At, B0); PG8_BAR; PG8_SCHED;
            PG8_LDB(B1, 1, 1); PG8_STAGE(PG8_SB(1, 0), b3, voffB);
            PG8_BAR; PG8_WAIT_L(0); PG8_MMA(0, 1, At, B1); PG8_BAR;
            PG8_LDA(At, 1, 1); PG8_STAGE(PG8_SA(1, 0), a3, voffA);
            PG8_BAR; PG8_WAIT_L(0); PG8_MMA(1, 0, At, B0); PG8_BAR; PG8_SCHED;
            PG8_STAGE(PG8_SB(1, 1), b3 + hstepB, voffB);
            PG8_WAIT_V(6); PG8_BAR; PG8_MMA(1, 1, At, B1); PG8_BAR;
        }
        { int fr2 = fr, fq2 = fq; asm volatile("" : "+v"(fr2), "+v"(fq2)); E(acc, cur, wr, wc, fr2, fq2); }
        if (!has_next) break;
#pragma unroll
        for (int a = 0; a < 2; ++a)
#pragma unroll
            for (int b = 0; b < 2; ++b)
#pragma unroll
                for (int m = 0; m < 4; ++m)
#pragma unroll
                    for (int n = 0; n < 2; ++n) acc[a][b][m][n] = (f32x4){0.f, 0.f, 0.f, 0.f};
        cur = nxt; cA = nA; cB = nB; ++ui; nt = cur.ks >= 0 ? 4 : ntFull;
    }
    PG8_WAIT_V(0);
    if (wr == 0) PG8_BAR;
    PG8_BAR;
#undef PG8_SA
#undef PG8_SB
#undef PG8_STAGE
#undef PG8_LDA
#undef PG8_LDB
#undef PG8_MMA
#undef PG8_WAIT_V
#undef PG8_WAIT_L
#undef PG8_BAR
#undef PG8_SCHED
}
}
using pg8::Unit;
typedef f32x4 AccT[2][2][4][2];
#define EPI_ROW(u, ai, m) ((u).pm * 256 + (ai) * 128 + wr * 64 + (m) * 16 + fr)
#define EPI_COLBASE(u, bj) ((u).pn * 256 + (bj) * 128 + wc * 32)

template <class Epi>
DI void run_gemm(LAS unsigned char* lds, const u16* A, int lda, const u16* Bt, int ldb, int M, int N, int K, const Epi& E) {
    pg8::Gemm g; g.A = A; g.Bt = Bt; g.M = M; g.N = N; g.K = K; g.lda = lda; g.ldb = ldb;
    pg8::StaticOrder S; S.init(M, N, (int)gridDim.x, (int)blockIdx.x);
    pg8::gemm_phase<Epi, pg8::StaticOrder>(lds, g, S, E);
    __syncthreads();
}
template <class Epi>
DI void run_gemm_mixed(LAS unsigned char* lds, const u16* A, int lda, const u16* Bt, int ldb, int N, int K, const Epi& E) {
    pg8::Gemm g; g.A = A; g.Bt = Bt; g.M = NTOK; g.N = N; g.K = K; g.lda = lda; g.ldb = ldb;
    pg8::MixedOrder S; S.init(N, K / 256, (int)gridDim.x, (int)blockIdx.x);
    pg8::gemm_phase<Epi, pg8::MixedOrder>(lds, g, S, E);
    __syncthreads();
}

DI void rope4(f32x4& v, const float* cs  ) {
    const f32x4 t = *(const f32x4*)cs;
    const float a0 = v[0] * t[0] - v[1] * t[1], a1 = v[0] * t[1] + v[1] * t[0];
    const float b0 = v[2] * t[2] - v[3] * t[3], b1 = v[2] * t[3] + v[3] * t[2];
    v = (f32x4){a0, a1, b0, b1};
}
DI u32x2 pack4(const f32x4& v) { u32x2 r; r.x = pk2(v[0], v[1]); r.y = pk2(v[2], v[3]); return r; }

struct EpiInEven {
    u16* U; u16* CQKV; u16* KC; float* ssq; float* sskv; const float* rope;
    DI void operator()(const AccT& acc, const Unit& u, int wr, int wc, int fr, int fq) const {
#pragma unroll
        for (int ai = 0; ai < 2; ++ai)
#pragma unroll
            for (int m = 0; m < 4; ++m) {
                const int row = EPI_ROW(u, ai, m);
#pragma unroll
                for (int bj = 0; bj < 2; ++bj) {
                    const int cb = EPI_COLBASE(u, bj);
                    if (cb < 512) {
#pragma unroll
                        for (int n = 0; n < 2; ++n) *(u32x2*)(U + (size_t)row * 512 + cb + n * 16 + 4 * fq) = pack4(acc[ai][bj][m][n]);
                    } else if (cb < 896) {
                        float ss = 0.f;
#pragma unroll
                        for (int n = 0; n < 2; ++n) { const f32x4 v = acc[ai][bj][m][n];
                            *(u32x2*)(CQKV + (size_t)row * 384 + (cb - 512) + n * 16 + 4 * fq) = pack4(v);
                            ss += v[0] * v[0] + v[1] * v[1] + v[2] * v[2] + v[3] * v[3]; }
                        ss += __shfl_xor(ss, 16); ss += __shfl_xor(ss, 32);
                        if (fq == 0) { if (cb < 768) ssq[(size_t)row * 8 + ((cb - 512) >> 5)] = ss; else sskv[(size_t)row * 4 + ((cb - 768) >> 5)] = ss; }
                    } else if (cb == 896) {
                        const int b = tok_b(row);
                        const int pos = row < NLAT ? 256 + (row & 8191) : ((row - NLAT) & 255);
#pragma unroll
                        for (int n = 0; n < 2; ++n) { f32x4 v = acc[ai][bj][m][n]; const int d0 = n * 16 + 4 * fq;
                            if (row < NLAT) rope4(v, rope + ((size_t)(row & 8191) * 16 + (d0 >> 1)) * 2);
                            const u32x2 w = pack4(v);
#pragma unroll
                            for (int h = 0; h < 8; ++h) *(u32x2*)(KC + ((size_t)(b * 8 + h) * LK + pos) * 96 + 64 + d0) = w; }
                    }
                }
            }
    }
};

struct EpiQ {
    u16* Q; const float* ssq; const float* rope;
    DI void operator()(const AccT& acc, const Unit& u, int wr, int wc, int fr, int fq) const {
        const float qs = 0.10206207261596577f * 1.4426950408889634f;
#pragma unroll
        for (int ai = 0; ai < 2; ++ai)
#pragma unroll
            for (int m = 0; m < 4; ++m) {
                const int row = EPI_ROW(u, ai, m);
                const f32x4 sa = *(const f32x4*)(ssq + (size_t)row * 8), sb = *(const f32x4*)(ssq + (size_t)row * 8 + 4);
                const float rstd = rsqrtf((((sa[0] + sa[1]) + (sa[2] + sa[3])) + ((sb[0] + sb[1]) + (sb[2] + sb[3]))) * (1.f / 256.f) + EPS) * qs;
                const int b = tok_b(row);
#pragma unroll
                for (int bj = 0; bj < 2; ++bj)
#pragma unroll
                    for (int n = 0; n < 2; ++n) {
                        const int col = EPI_COLBASE(u, bj) + n * 16 + 4 * fq, h = col / 96, dd = col - h * 96;
                        f32x4 v = acc[ai][bj][m][n];
                        if (dd >= 64 && row < NLAT) rope4(v, rope + ((size_t)(row & 8191) * 16 + ((dd - 64) >> 1)) * 2);
                        v = v * rstd;
                        u16* dst = row < NLAT ? Q + ((size_t)(b * 8 + h) * SEQ + (row & 8191)) * 96 + dd
                                              : Q + (size_t)NLAT * 768 + ((size_t)(b * 8 + h) * CTXL + ((row - NLAT) & 255)) * 96 + dd;
                        *(u32x2*)dst = pack4(v);
                    }
            }
    }
};

struct EpiKV {
    u16* KC; u16* VT; const float* sskv;
    DI void operator()(const AccT& acc, const Unit& u, int wr, int wc, int fr, int fq) const {
#pragma unroll
        for (int ai = 0; ai < 2; ++ai)
#pragma unroll
            for (int m = 0; m < 4; ++m) {
                const int row = EPI_ROW(u, ai, m);
                const f32x4 sa = *(const f32x4*)(sskv + (size_t)row * 4);
                const float rstd = rsqrtf(((sa[0] + sa[1]) + (sa[2] + sa[3])) * (1.f / 128.f) + EPS);
                const int b = tok_b(row);
                const int pos = row < NLAT ? 256 + (row & 8191) : ((row - NLAT) & 255);
#pragma unroll
                for (int bj = 0; bj < 2; ++bj)
#pragma unroll
                    for (int n = 0; n < 2; ++n) {
                        const int col = EPI_COLBASE(u, bj) + n * 16 + 4 * fq, h = col >> 7, c2 = col & 127;
                        const f32x4 v = acc[ai][bj][m][n] * rstd;
                        if (c2 < 64) *(u32x2*)(KC + ((size_t)(b * 8 + h) * LK + pos) * 96 + c2) = pack4(v);
                        else {
#pragma unroll
                            for (int j = 0; j < 4; ++j) VT[((size_t)(b * 8 + h) * 64 + (c2 - 64 + j)) * LK + pos] = f2bf(v[j]);
                        }
                    }
            }
    }
};

struct EpiGlu {
    const u16* Z; u16* HB;
    DI void operator()(const AccT& acc, const Unit& u, int wr, int wc, int fr, int fq) const {
#pragma unroll
        for (int ai = 0; ai < 2; ++ai)
#pragma unroll
            for (int m = 0; m < 4; ++m) {
                const int row = EPI_ROW(u, ai, m);
#pragma unroll
                for (int bj = 0; bj < 2; ++bj)
#pragma unroll
                    for (int n = 0; n < 2; ++n) {
                        const int col = EPI_COLBASE(u, bj) + n * 16 + 4 * fq;
                        const u32x2 z = *(const u32x2*)(Z + (size_t)row * 512 + col);
                        const f32x4 a = acc[ai][bj][m][n];
                        f32x4 o; o[0] = bflo(z.x) * sigmoidf_(a[0]); o[1] = bfhi(z.x) * sigmoidf_(a[1]); o[2] = bflo(z.y) * sigmoidf_(a[2]); o[3] = bfhi(z.y) * sigmoidf_(a[3]);
                        *(u32x2*)(HB + (size_t)row * 1024 + col) = pack4(o);
                    }
            }
    }
};

struct EpiRes {
    const float* srcLat; const float* srcCtx; const float* gate  ; float* X; float* part;
    DI void operator()(const AccT& acc, const Unit& u, int wr, int wc, int fr, int fq) const {
#pragma unroll
        for (int ai = 0; ai < 2; ++ai)
#pragma unroll
            for (int m = 0; m < 4; ++m) {
                const int row = EPI_ROW(u, ai, m);
                if (u.ks >= 0) {
                    float* pr = part + ((size_t)u.ks * NCTX + (row - NLAT)) * 1024;
#pragma unroll
                    for (int bj = 0; bj < 2; ++bj)
#pragma unroll
                        for (int n = 0; n < 2; ++n) *(f32x4*)(pr + EPI_COLBASE(u, bj) + n * 16 + 4 * fq) = acc[ai][bj][m][n];
                } else {
                    const float* src = row < NLAT ? srcLat + (size_t)row * 1024 : srcCtx + (size_t)(row - NLAT) * 1024;
                    const float* gv = gate + tok_bidx(row) * 6144;
#pragma unroll
                    for (int bj = 0; bj < 2; ++bj)
#pragma unroll
                        for (int n = 0; n < 2; ++n) {
                            const int col = EPI_COLBASE(u, bj) + n * 16 + 4 * fq;
                            const f32x4 s = *(const f32x4*)(src + col), gg = *(const f32x4*)(gv + col);
                            *(f32x4*)(X + (size_t)row * 1024 + col) = s + gg * acc[ai][bj][m][n];
                        }
                }
            }
    }
};

struct EpiFFN1 {
    u16* ACT;
    DI void operator()(const AccT& acc, const Unit& u, int wr, int wc, int fr, int fq) const {
#pragma unroll
        for (int ai = 0; ai < 2; ++ai)
#pragma unroll
            for (int m = 0; m < 4; ++m) {
                const int row = EPI_ROW(u, ai, m);
#pragma unroll
                for (int bj = 0; bj < 2; ++bj) {
                    const int col = (EPI_COLBASE(u, bj) >> 1) + 4 * fq;
                    const f32x4 g = acc[ai][bj][m][0], up = acc[ai][bj][m][1];
                    f32x4 o; o[0] = siluf_(g[0]) * up[0]; o[1] = siluf_(g[1]) * up[1]; o[2] = siluf_(g[2]) * up[2]; o[3] = siluf_(g[3]) * up[3];
                    *(u32x2*)(ACT + (size_t)row * DFF + col) = pack4(o);
                }
            }
    }
};

struct EpiInOdd {
    u16* PROJ; const float* rope;
    DI void operator()(const AccT& acc, const Unit& u, int wr, int wc, int fr, int fq) const {
#pragma unroll
        for (int ai = 0; ai < 2; ++ai)
#pragma unroll
            for (int m = 0; m < 4; ++m) {
                const int row = EPI_ROW(u, ai, m);
#pragma unroll
                for (int bj = 0; bj < 2; ++bj) {
                    const int cb = EPI_COLBASE(u, bj), seg = cb >> 9;
#pragma unroll
                    for (int n = 0; n < 2; ++n) {
                        const int col = cb + n * 16 + 4 * fq;
                        f32x4 v = acc[ai][bj][m][n];
                        if (seg < 2) {
                            if (row < NLAT) rope4(v, rope + ((size_t)(row & 8191) * 64 + ((col & 127) >> 1)) * 2);
                            if (seg == 1) v = v * 0.08838834764831845f;
                        }
                        *(u32x2*)(PROJ + (size_t)row * 4608 + col) = pack4(v);
                    }
                }
            }
    }
};

struct ConvJob { const float* src; u16* dst; const float* rowscale; int K, N, lds_, Npad, ldd, koff, inter; };
DI void conv_job(const ConvJob& J, float* tile) {
    const int tid = tidx(), ntn = J.Npad / 64, tiles = (J.K / 64) * ntn;
    for (int t = blockIdx.x; t < tiles; t += gridDim.x) {
        const int kt = t / ntn, nt = t - kt * ntn;
#pragma unroll
        for (int i = 0; i < 8; ++i) {
            const int kl = (tid >> 6) + 8 * i, nl = tid & 63, k = kt * 64 + kl, n = nt * 64 + nl;
            float v = 0.f;
            if (n < J.N) { v = J.src[(size_t)k * J.lds_ + n]; if (J.rowscale) v *= J.rowscale[k]; }
            tile[kl * 65 + nl] = v;
        }
        __syncthreads();
#pragma unroll
        for (int i = 0; i < 8; ++i) {
            const int nl = (tid >> 6) + 8 * i, kl = tid & 63, n = nt * 64 + nl;
            const int drow = J.inter ? (32 * (n >> 4) + (n & 15) + (J.inter == 2 ? 16 : 0)) : n;
            J.dst[(size_t)drow * J.ldd + J.koff + kt * 64 + kl] = f2bf(tile[kl * 65 + nl]);
        }
        __syncthreads();
    }
}
DI void conv_mixer_weights(const Params& p, int li, float* tile) {
    unsigned char* W = p.ws + OFF_WMIX;
    const int j = li >> 1;
    if ((li & 1) == 0) {
        ConvJob a{p.in[11] + (size_t)j * 1024 * 928, (u16*)(W + WE_IN), nullptr, 1024, 928, 928, 1024, 1024, 0, 0}; conv_job(a, tile);
        ConvJob b{p.in[12] + (size_t)j * 1024 * 1024, (u16*)(W + WE_OUT), nullptr, 1024, 1024, 1024, 1024, 1024, 0, 0}; conv_job(b, tile);
        ConvJob c{p.in[21] + (size_t)j * 512 * 512, (u16*)(W + WE_GLU), nullptr, 512, 512, 512, 512, 512, 0, 0}; conv_job(c, tile);
        ConvJob d{p.in[23] + (size_t)j * 256 * 768, (u16*)(W + WE_UQ), p.in[22] + j * 256, 256, 768, 768, 768, 256, 0, 0}; conv_job(d, tile);
        ConvJob e{p.in[25] + (size_t)j * 128 * 1024, (u16*)(W + WE_UKV), p.in[24] + j * 128, 128, 1024, 1024, 1024, 256, 128, 0}; conv_job(e, tile);
        u16* z = (u16*)(W + WE_UKV);
        for (int i = blockIdx.x * 512 + tidx(); i < 1024 * 128; i += gridDim.x * 512) z[(size_t)(i >> 7) * 256 + (i & 127)] = 0;
    } else {
        ConvJob a{p.in[26] + (size_t)j * 1024 * 4608, (u16*)(W + WO_IN), nullptr, 1024, 4608, 4608, 4608, 1024, 0, 0}; conv_job(a, tile);
        ConvJob b{p.in[27] + (size_t)j * 1024 * 1024, (u16*)(W + WO_OUT), nullptr, 1024, 1024, 1024, 1024, 1024, 0, 0}; conv_job(b, tile);
    }
}
DI void conv_ffn_weights(const Params& p, int li, float* tile) {
    unsigned char* W = p.ws + OFF_WFFN;
    ConvJob a{p.in[8] + (size_t)li * 1024 * DFF, (u16*)(W + WF_13), nullptr, 1024, DFF, DFF, DFF, 1024, 0, 1}; conv_job(a, tile);
    ConvJob b{p.in[9] + (size_t)li * 1024 * DFF, (u16*)(W + WF_13), nullptr, 1024, DFF, DFF, DFF, 1024, 0, 2}; conv_job(b, tile);
    ConvJob c{p.in[10] + (size_t)li * DFF * 1024, (u16*)(W + WF_2), nullptr, DFF, 1024, 1024, 1024, DFF, 0, 0}; conv_job(c, tile);
}

DI void norm_rows(const float* srcLat, const float* srcCtx, const float* g, const float* modl, int aoff, int soff, u16* H,
                  const float* part, int KS, const float* gctx, float* xw) {
    const int wid = tidx() >> 6, lane = tidx() & 63;
    for (int row = blockIdx.x * 8 + wid; row < NTOK; row += gridDim.x * 8) {
        const float* src = row < NLAT ? srcLat + (size_t)row * 1024 : srcCtx + (size_t)(row - NLAT) * 1024;
        const float* mv = modl + tok_bidx(row) * 6144;
        f32x4 v[4]; float ss = 0.f;
#pragma unroll
        for (int i = 0; i < 4; ++i) v[i] = *(const f32x4*)(src + i * 256 + lane * 4);
        if (part != nullptr && row >= NLAT) {
#pragma unroll
            for (int i = 0; i < 4; ++i) { const int col = i * 256 + lane * 4; f32x4 a = (f32x4){0.f, 0.f, 0.f, 0.f};
                for (int k = 0; k < KS; ++k) a += *(const f32x4*)(part + ((size_t)k * NCTX + (row - NLAT)) * 1024 + col);
                v[i] += *(const f32x4*)(gctx + col) * a;
                *(f32x4*)(xw + (size_t)row * 1024 + col) = v[i]; }
        }
#pragma unroll
        for (int i = 0; i < 4; ++i) ss += v[i][0] * v[i][0] + v[i][1] * v[i][1] + v[i][2] * v[i][2] + v[i][3] * v[i][3];
#pragma unroll
        for (int o = 1; o < 64; o <<= 1) ss += __shfl_xor(ss, o);
        const float rstd = rsqrtf(ss * (1.f / 1024.f) + EPS);
#pragma unroll
        for (int i = 0; i < 4; ++i) {
            const int col = i * 256 + lane * 4;
            const f32x4 gg = *(const f32x4*)(g + col), a = *(const f32x4*)(mv + aoff + col), s = *(const f32x4*)(mv + soff + col);
            const f32x4 h = v[i] * rstd * gg * (a + 1.f) + s;
            *(u32x2*)(H + (size_t)row * 1024 + col) = pack4(h);
        }
    }
}
DI void final_norm_rows(const float* X, const float* g, float* out) {
    const int wid = tidx() >> 6, lane = tidx() & 63;
    for (int row = blockIdx.x * 8 + wid; row < NLAT; row += gridDim.x * 8) {
        const float* src = X + (size_t)row * 1024;
        f32x4 v[4]; float ss = 0.f;
#pragma unroll
        for (int i = 0; i < 4; ++i) { v[i] = *(const f32x4*)(src + i * 256 + lane * 4); ss += v[i][0] * v[i][0] + v[i][1] * v[i][1] + v[i][2] * v[i][2] + v[i][3] * v[i][3]; }
#pragma unroll
        for (int o = 1; o < 64; o <<= 1) ss += __shfl_xor(ss, o);
        const float rstd = rsqrtf(ss * (1.f / 1024.f) + EPS);
#pragma unroll
        for (int i = 0; i < 4; ++i) { const int col = i * 256 + lane * 4; *(f32x4*)(out + (size_t)row * 1024 + col) = v[i] * rstd * *(const f32x4*)(g + col); }
    }
}

DI void prep_phase(const Params& p, float* ldsf) {
    const int tid = tidx(), gt = blockIdx.x * 512 + tid, gs = gridDim.x * 512;
    float* mod = (float*)(p.ws + OFF_MOD);
    {
        for (int i = tid; i < 3072; i += 512) { const int v = i >> 10, k = i & 1023; const float x = v < 2 ? p.in[1][v * 1024 + k] : p.in[3][k]; ldsf[i] = siluf_(x); }
        __syncthreads();
        for (int u = blockIdx.x; u < 4 * 12 * 16; u += gridDim.x) {
            const int ks = u & 15, cbk = (u >> 4) % 12, li = u / 192, n = cbk * 512 + tid, k0 = ks * 64;
            const float* w = p.in[4] + ((size_t)li * 1024 + k0) * 6144 + n;
            float a0 = 0.f, a1 = 0.f, a2 = 0.f;
#pragma unroll 16
            for (int k = 0; k < 64; ++k) { const float wv = w[(size_t)k * 6144]; a0 += ldsf[k0 + k] * wv; a1 += ldsf[1024 + k0 + k] * wv; a2 += ldsf[2048 + k0 + k] * wv; }
            if (ks == 0) { const float bm = p.in[5][li * 6144 + n]; a0 += bm; a1 += bm; a2 += bm; }
            float* mp = (float*)(p.ws + OFF_MODP) + (size_t)ks * (4 * 3 * 6144);
            mp[(li * 3 + 0) * 6144 + n] = a0; mp[(li * 3 + 1) * 6144 + n] = a1; mp[(li * 3 + 2) * 6144 + n] = a2;
        }
        __syncthreads();
    }
    float* rm = (float*)(p.ws + OFF_RMLA); float* rr = (float*)(p.ws + OFF_RRET);
    for (int i = gt; i < 8192 * 16; i += gs) { const int l = i >> 4, q = i & 15, r = l >> 6, c = l & 63;
        const float inv = powf(10000.f, -(float)(q & 7) / 8.f); const float ang = (float)(q < 8 ? r : c) * inv;
        float sn, cs; sincosf(ang, &sn, &cs); rm[2 * i] = cs; rm[2 * i + 1] = sn; }
    for (int i = gt; i < 8192 * 64; i += gs) { const int l = i >> 6, q = i & 63, r = l >> 6, c = l & 63;
        const float inv = powf(10000.f, -(float)(q & 31) / 32.f); const float ang = (float)(q < 32 ? r : c) * inv;
        float sn, cs; sincosf(ang, &sn, &cs); rr[2 * i] = cs; rr[2 * i + 1] = sn; }
    float* lb = (float*)(p.ws + OFF_LB);
    for (int i = gt; i < 512; i += gs) { const float a = p.in[29][i], b = p.in[29][512 + i], c = p.in[29][1024 + i]; const float mx = fmaxf(a, fmaxf(b, c));
        const float ea = expf(a - mx), eb = expf(b - mx), ec = expf(c - mx), s = ea + eb + ec; lb[i] = ea / s; lb[512 + i] = (ea + eb) / s; }
    float2* sab = (float2*)(p.ws + OFF_SAB); float2* sa64 = (float2*)(p.ws + OFF_SA64); float2* sbb = (float2*)(p.ws + OFF_SBB); u16* scc = (u16*)(p.ws + OFF_SCC);
    for (int i = gt; i < 2 * 2 * 2048; i += gs) {
        const int gp = i & 2047, jr = i >> 11, g = gp >> 6, pp = gp & 63;
        const double are = p.in[13][i], aim = p.in[14][i], dt = exp((double)p.in[15][jr * 32 + g]);
        const double mag = exp(are * dt), abr = mag * cos(aim * dt), abi = mag * sin(aim * dt);
        sab[i] = make_float2((float)abr, (float)abi);
        const double m64 = exp(are * dt * 64.0); sa64[i] = make_float2((float)(m64 * cos(aim * dt * 64.0)), (float)(m64 * sin(aim * dt * 64.0)));
        const double nr = abr - 1.0, ni = abi, den = are * are + aim * aim;
        const double fr = (nr * are + ni * aim) / den, fi = (ni * are - nr * aim) / den;
        { u16* sbbt = (u16*)sbb;
          for (int k = 0; k < 16; ++k) { const double br = p.in[16][(size_t)i * 16 + k], bi = p.in[17][(size_t)i * 16 + k];
            sbbt[((size_t)(jr * 32 + g) * 128 + pp) * 16 + k] = f2bf((float)(fr * br - fi * bi));
            sbbt[((size_t)(jr * 32 + g) * 128 + 64 + pp) * 16 + k] = f2bf((float)(fr * bi + fi * br)); } }
        for (int k = 0; k < 16; ++k) { const size_t ci = ((size_t)(jr * 32 + g) * 16 + k) * 64 + pp;
            scc[((size_t)(jr * 32 + g) * 16 + k) * 128 + pp] = f2bf(p.in[18][ci]); scc[((size_t)(jr * 32 + g) * 16 + k) * 128 + 64 + pp] = f2bf(-p.in[19][ci]); }
    }
    conv_mixer_weights(p, 0, ldsf);
}

constexpr int AT_KROW = 208, AT_VROW = 144, AT_KBUF = 64 * AT_KROW, AT_VBUF = 64 * AT_VROW, AT_BUF = AT_KBUF + AT_VBUF;
DI void attn_unit(LAS unsigned char* lds, const u16* Qp, const u16* Kp, const u16* Vp, int nkt, u16* outp) {
    const int tid = tidx(), wid = tid >> 6, lane = tid & 63, l31 = lane & 31, hh = lane >> 5;
    bf16x8 qf[6];
    { const u16* qr = Qp + (size_t)(wid * 32 + l31) * 96 + 8 * hh;
#pragma unroll
      for (int s = 0; s < 6; ++s) qf[s] = *(const bf16x8*)(qr + 16 * s); }
    f32x16 o0, o1;
#pragma unroll
    for (int i = 0; i < 16; ++i) { o0[i] = 0.f; o1[i] = 0.f; }
    float m_run = -1e30f, lsum = 0.f;
    const int kr0 = tid / 12, kp0 = tid - kr0 * 12, c1 = 512 + tid, kr1 = c1 / 12, kp1 = c1 - kr1 * 12, vr = tid >> 3, vp = tid & 7;
    u32x4 rk0, rk1 = (u32x4){0u, 0u, 0u, 0u}, rv;
    rk0 = *(const u32x4*)(Kp + (size_t)kr0 * 96 + kp0 * 8);
    if (tid < 256) rk1 = *(const u32x4*)(Kp + (size_t)kr1 * 96 + kp1 * 8);
    rv = *(const u32x4*)(Vp + (size_t)vr * LK + vp * 8);
    *(LAS u32x4*)(lds + kr0 * AT_KROW + kp0 * 16) = rk0;
    if (tid < 256) *(LAS u32x4*)(lds + kr1 * AT_KROW + kp1 * 16) = rk1;
    *(LAS u32x4*)(lds + AT_KBUF + vr * AT_VROW + vp * 16) = rv;
    __syncthreads();
    for (int kt = 0; kt < nkt; ++kt) {
        LAS unsigned char* kb_ = lds + (kt & 1) * AT_BUF; LAS unsigned char* vb_ = kb_ + AT_KBUF;
        const bool more = kt + 1 < nkt;
        if (more) { const u16* kn = Kp + (size_t)(kt + 1) * 64 * 96; const u16* vn = Vp + (size_t)(kt + 1) * 64;
            rk0 = *(const u32x4*)(kn + (size_t)kr0 * 96 + kp0 * 8);
            if (tid < 256) rk1 = *(const u32x4*)(kn + (size_t)kr1 * 96 + kp1 * 8);
            rv = *(const u32x4*)(vn + (size_t)vr * LK + vp * 8); }
        f32x16 st0, st1;
#pragma unroll
        for (int i = 0; i < 16; ++i) { st0[i] = 0.f; st1[i] = 0.f; }
#pragma unroll
        for (int s = 0; s < 6; ++s) {
            const bf16x8 a0 = *(const LAS bf16x8*)(kb_ + l31 * AT_KROW + (16 * s + 8 * hh) * 2);
            const bf16x8 a1 = *(const LAS bf16x8*)(kb_ + (32 + l31) * AT_KROW + (16 * s + 8 * hh) * 2);
            st0 = MFMA32(a0, qf[s], st0); st1 = MFMA32(a1, qf[s], st1);
        }
        float mx = st0[0];
#pragma unroll
        for (int i = 0; i < 16; ++i) { mx = fmaxf(mx, st0[i]); mx = fmaxf(mx, st1[i]); }
        mx = fmaxf(mx, __shfl_xor(mx, 32));
        const float m_new = fmaxf(m_run, mx), alpha = __builtin_amdgcn_exp2f(m_run - m_new);
        m_run = m_new;
        float ps = 0.f;
#pragma unroll
        for (int i = 0; i < 16; ++i) { st0[i] = __builtin_amdgcn_exp2f(st0[i] - m_new); st1[i] = __builtin_amdgcn_exp2f(st1[i] - m_new); ps += st0[i] + st1[i]; }
        lsum = lsum * alpha + ps;
#pragma unroll
        for (int i = 0; i < 16; ++i) { o0[i] *= alpha; o1[i] *= alpha; }
#pragma unroll
        for (int kb = 0; kb < 2; ++kb)
#pragma unroll
            for (int s = 0; s < 2; ++s) {
                u32x4 pw;
                if (kb == 0) { pw.x = pk2(st0[8 * s], st0[8 * s + 1]); pw.y = pk2(st0[8 * s + 2], st0[8 * s + 3]); pw.z = pk2(st0[8 * s + 4], st0[8 * s + 5]); pw.w = pk2(st0[8 * s + 6], st0[8 * s + 7]); }
                else         { pw.x = pk2(st1[8 * s], st1[8 * s + 1]); pw.y = pk2(st1[8 * s + 2], st1[8 * s + 3]); pw.z = pk2(st1[8 * s + 4], st1[8 * s + 5]); pw.w = pk2(st1[8 * s + 6], st1[8 * s + 7]); }
                const bf16x8 pb = __builtin_bit_cast(bf16x8, pw);
                const int koff = (32 * kb + 16 * s + 4 * hh) * 2;
                { const u32x2 lo = *(const LAS u32x2*)(vb_ + l31 * AT_VROW + koff), hi = *(const LAS u32x2*)(vb_ + l31 * AT_VROW + koff + 16);
                  u32x4 va; va.x = lo.x; va.y = lo.y; va.z = hi.x; va.w = hi.y; o0 = MFMA32(__builtin_bit_cast(bf16x8, va), pb, o0); }
                { const u32x2 lo = *(const LAS u32x2*)(vb_ + (32 + l31) * AT_VROW + koff), hi = *(const LAS u32x2*)(vb_ + (32 + l31) * AT_VROW + koff + 16);
                  u32x4 va; va.x = lo.x; va.y = lo.y; va.z = hi.x; va.w = hi.y; o1 = MFMA32(__builtin_bit_cast(bf16x8, va), pb, o1); }
            }
        if (more) { LAS unsigned char* nb = lds + ((kt + 1) & 1) * AT_BUF;
            *(LAS u32x4*)(nb + kr0 * AT_KROW + kp0 * 16) = rk0;
            if (tid < 256) *(LAS u32x4*)(nb + kr1 * AT_KROW + kp1 * 16) = rk1;
            *(LAS u32x4*)(nb + AT_KBUF + vr * AT_VROW + vp * 16) = rv; }
        __syncthreads();
    }
    const float lt = lsum + __shfl_xor(lsum, 32), inv = 1.f / lt;
    u16* orow = outp + (size_t)(wid * 32 + l31) * 1024;
#pragma unroll
    for (int g = 0; g < 4; ++g) {
        u32x2 w0, w1;
        w0.x = pk2(o0[4 * g] * inv, o0[4 * g + 1] * inv); w0.y = pk2(o0[4 * g + 2] * inv, o0[4 * g + 3] * inv);
        w1.x = pk2(o1[4 * g] * inv, o1[4 * g + 1] * inv); w1.y = pk2(o1[4 * g + 2] * inv, o1[4 * g + 3] * inv);
        *(u32x2*)(orow + 8 * g + 4 * hh) = w0; *(u32x2*)(orow + 32 + 8 * g + 4 * hh) = w1;
    }
}


DI void attn_unit64(LAS unsigned char* lds, const u16* Qp, const u16* Kp, const u16* Vp, int nkt, u16* outp) {
    const int tid = tidx(), wid = tid >> 6, lane = tid & 63, l31 = lane & 31, hh = lane >> 5;
    bf16x8 qf0[6], qf1[6];
    { const u16* qr = Qp + (size_t)(wid * 64 + l31) * 96 + 8 * hh;
#pragma unroll
      for (int s = 0; s < 6; ++s) { qf0[s] = *(const bf16x8*)(qr + 16 * s); qf1[s] = *(const bf16x8*)(qr + 32 * 96 + 16 * s); } }
    f32x16 oa0, oa1, ob0, ob1;
#pragma unroll
    for (int i = 0; i < 16; ++i) { oa0[i] = 0.f; oa1[i] = 0.f; ob0[i] = 0.f; ob1[i] = 0.f; }
    float ma = -1e30f, mb = -1e30f, la = 0.f, lb = 0.f;
    const int kr0 = tid / 12, kp0 = tid - kr0 * 12, c1 = 512 + tid, kr1 = c1 / 12, kp1 = c1 - kr1 * 12, vr = tid >> 3, vp = tid & 7;
    u32x4 rk0, rk1 = (u32x4){0u, 0u, 0u, 0u}, rv;
    rk0 = *(const u32x4*)(Kp + (size_t)kr0 * 96 + kp0 * 8);
    if (tid < 256) rk1 = *(const u32x4*)(Kp + (size_t)kr1 * 96 + kp1 * 8);
    rv = *(const u32x4*)(Vp + (size_t)vr * LK + vp * 8);
    *(LAS u32x4*)(lds + kr0 * AT_KROW + kp0 * 16) = rk0;
    if (tid < 256) *(LAS u32x4*)(lds + kr1 * AT_KROW + kp1 * 16) = rk1;
    *(LAS u32x4*)(lds + AT_KBUF + vr * AT_VROW + vp * 16) = rv;
    __syncthreads();
    for (int kt = 0; kt < nkt; ++kt) {
        LAS unsigned char* kb_ = lds + (kt & 1) * AT_BUF; LAS unsigned char* vb_ = kb_ + AT_KBUF;
        const bool more = kt + 1 < nkt;
        if (more) { const u16* kn = Kp + (size_t)(kt + 1) * 64 * 96; const u16* vn = Vp + (size_t)(kt + 1) * 64;
            rk0 = *(const u32x4*)(kn + (size_t)kr0 * 96 + kp0 * 8);
            if (tid < 256) rk1 = *(const u32x4*)(kn + (size_t)kr1 * 96 + kp1 * 8);
            rv = *(const u32x4*)(vn + (size_t)vr * LK + vp * 8); }
        f32x16 sa0, sa1, sb0, sb1;
#pragma unroll
        for (int i = 0; i < 16; ++i) { sa0[i] = 0.f; sa1[i] = 0.f; sb0[i] = 0.f; sb1[i] = 0.f; }
#pragma unroll
        for (int s = 0; s < 6; ++s) {
            const bf16x8 a0 = *(const LAS bf16x8*)(kb_ + l31 * AT_KROW + (16 * s + 8 * hh) * 2);
            const bf16x8 a1 = *(const LAS bf16x8*)(kb_ + (32 + l31) * AT_KROW + (16 * s + 8 * hh) * 2);
            sa0 = MFMA32(a0, qf0[s], sa0); sa1 = MFMA32(a1, qf0[s], sa1);
            sb0 = MFMA32(a0, qf1[s], sb0); sb1 = MFMA32(a1, qf1[s], sb1);
        }
        u32x4 pa[4], pb[4];
#define AT_SOFTMAX(S0, S1, M, L, O0, O1, P) do { \
        float mx = S0[0]; \
        _Pragma("unroll") for (int i = 0; i < 16; ++i) { mx = fmaxf(mx, S0[i]); mx = fmaxf(mx, S1[i]); } \
        { const auto sw_ = __builtin_amdgcn_permlane32_swap(__float_as_uint(mx), __float_as_uint(mx), false, false); \
          mx = fmaxf(__uint_as_float(sw_[0]), __uint_as_float(sw_[1])); }     \
        const float m_new = fmaxf(M, mx); \
        if (__builtin_amdgcn_ballot_w64(mx > M + 8.0f) != 0ull) {     const float alpha = __builtin_amdgcn_exp2f(M - m_new); M = m_new; L *= alpha; \
            _Pragma("unroll") for (int i = 0; i < 16; ++i) { O0[i] *= alpha; O1[i] *= alpha; } } \
        float ps = 0.f; \
        _Pragma("unroll") for (int i = 0; i < 16; ++i) { S0[i] = __builtin_amdgcn_exp2f(S0[i] - M); S1[i] = __builtin_amdgcn_exp2f(S1[i] - M); ps += S0[i] + S1[i]; } \
        L += ps; \
        _Pragma("unroll") for (int s = 0; s < 2; ++s) { \
            P[s].x = pk2(S0[8 * s], S0[8 * s + 1]); P[s].y = pk2(S0[8 * s + 2], S0[8 * s + 3]); P[s].z = pk2(S0[8 * s + 4], S0[8 * s + 5]); P[s].w = pk2(S0[8 * s + 6], S0[8 * s + 7]); \
            P[2 + s].x = pk2(S1[8 * s], S1[8 * s + 1]); P[2 + s].y = pk2(S1[8 * s + 2], S1[8 * s + 3]); P[2 + s].z = pk2(S1[8 * s + 4], S1[8 * s + 5]); P[2 + s].w = pk2(S1[8 * s + 6], S1[8 * s + 7]); } \
        } while (0)
        AT_SOFTMAX(sa0, sa1, ma, la, oa0, oa1, pa);
        AT_SOFTMAX(sb0, sb1, mb, lb, ob0, ob1, pb);
#undef AT_SOFTMAX
#pragma unroll
        for (int kb = 0; kb < 2; ++kb)
#pragma unroll
            for (int s = 0; s < 2; ++s) {
                const int koff = (32 * kb + 16 * s + 4 * hh) * 2;
                const u32x2 lo0 = *(const LAS u32x2*)(vb_ + l31 * AT_VROW + koff), hi0 = *(const LAS u32x2*)(vb_ + l31 * AT_VROW + koff + 16);
                const u32x2 lo1 = *(const LAS u32x2*)(vb_ + (32 + l31) * AT_VROW + koff), hi1 = *(const LAS u32x2*)(vb_ + (32 + l31) * AT_VROW + koff + 16);
                u32x4 va0, va1; va0.x = lo0.x; va0.y = lo0.y; va0.z = hi0.x; va0.w = hi0.y; va1.x = lo1.x; va1.y = lo1.y; va1.z = hi1.x; va1.w = hi1.y;
                const bf16x8 v0 = __builtin_bit_cast(bf16x8, va0), v1 = __builtin_bit_cast(bf16x8, va1);
                const bf16x8 pA = __builtin_bit_cast(bf16x8, pa[kb * 2 + s]), pB = __builtin_bit_cast(bf16x8, pb[kb * 2 + s]);
                oa0 = MFMA32(v0, pA, oa0); oa1 = MFMA32(v1, pA, oa1);
                ob0 = MFMA32(v0, pB, ob0); ob1 = MFMA32(v1, pB, ob1);
            }
        if (more) { LAS unsigned char* nb = lds + ((kt + 1) & 1) * AT_BUF;
            *(LAS u32x4*)(nb + kr0 * AT_KROW + kp0 * 16) = rk0;
            if (tid < 256) *(LAS u32x4*)(nb + kr1 * AT_KROW + kp1 * 16) = rk1;
            *(LAS u32x4*)(nb + AT_KBUF + vr * AT_VROW + vp * 16) = rv; }
        __syncthreads();
    }
    {   const float lt = la + __shfl_xor(la, 32), inv = 1.f / lt;
        u16* orow = outp + (size_t)(wid * 64 + l31) * 1024;
#pragma unroll
        for (int g = 0; g < 4; ++g) { u32x2 w0, w1;
            w0.x = pk2(oa0[4 * g] * inv, oa0[4 * g + 1] * inv); w0.y = pk2(oa0[4 * g + 2] * inv, oa0[4 * g + 3] * inv);
            w1.x = pk2(oa1[4 * g] * inv, oa1[4 * g + 1] * inv); w1.y = pk2(oa1[4 * g + 2] * inv, oa1[4 * g + 3] * inv);
            *(u32x2*)(orow + 8 * g + 4 * hh) = w0; *(u32x2*)(orow + 32 + 8 * g + 4 * hh) = w1; } }
    {   const float lt = lb + __shfl_xor(lb, 32), inv = 1.f / lt;
        u16* orow = outp + (size_t)(wid * 64 + 32 + l31) * 1024;
#pragma unroll
        for (int g = 0; g < 4; ++g) { u32x2 w0, w1;
            w0.x = pk2(ob0[4 * g] * inv, ob0[4 * g + 1] * inv); w0.y = pk2(ob0[4 * g + 2] * inv, ob0[4 * g + 3] * inv);
            w1.x = pk2(ob1[4 * g] * inv, ob1[4 * g + 1] * inv); w1.y = pk2(ob1[4 * g + 2] * inv, ob1[4 * g + 3] * inv);
            *(u32x2*)(orow + 8 * g + 4 * hh) = w0; *(u32x2*)(orow + 32 + 8 * g + 4 * hh) = w1; } }
}

DI int s5_rowbase(int b, int jc) { return jc < 4 ? NLAT + b * 256 + jc * 64 : b * 8192 + (jc - 4) * 64; }
constexpr int S5_BU = 16 * 132 * 4, S5_HB = 16 * 136 * 2, S5_WAVE = S5_BU + S5_HB;
#define S5_WAVE_SYNC() do { asm volatile("s_waitcnt vmcnt(0) lgkmcnt(0)" ::: "memory"); __builtin_amdgcn_wave_barrier(); } while (0)
template <bool WITH_C>
DI void s5_dir(const Params& p, int j, int dir, int g, int rowbase, float& hr, float& hi, f32x4 (&acc)[4], unsigned char* lw) {
    const int lane = tidx() & 63, lq = lane >> 4, l15 = lane & 15, gp = g * 64 + lane;
    const int tdir = (j * 2 + dir);
    const float2 A = ((const float2*)(p.ws + OFF_SAB))[tdir * 2048 + gp];
    const u16* U = (const u16*)(p.ws + OFF_BIG + BE_U);
    const u16* sbbt = (const u16*)(p.ws + OFF_SBB) + (size_t)(tdir * 32 + g) * 128 * 16;
    const bf16x8 zero8 = (bf16x8){0, 0, 0, 0, 0, 0, 0, 0};
    bf16x8 bfr[8];
#pragma unroll
    for (int nt = 0; nt < 8; ++nt) bfr[nt] = lq < 2 ? *(const bf16x8*)(sbbt + (16 * nt + l15) * 16 + 8 * lq) : zero8;
    bf16x8 cf[4];
    if (WITH_C) { const u16* cp = (const u16*)(p.ws + OFF_SCC) + ((size_t)(tdir * 32 + g) * 16 + l15) * 128 + 8 * lq;
#pragma unroll
        for (int s = 0; s < 4; ++s) cf[s] = *(const bf16x8*)(cp + 32 * s); }
    bf16x8 ua[4];
#pragma unroll
    for (int sb = 0; sb < 4; ++sb) ua[sb] = lq < 2 ? *(const bf16x8*)(U + (size_t)(rowbase + 16 * sb + l15) * 512 + g * 16 + 8 * lq) : zero8;
    float* bu = (float*)lw; u16* hb = (u16*)(lw + S5_BU);
#pragma unroll
    for (int sbi = 0; sbi < 4; ++sbi) {
        const int sb = dir ? 3 - sbi : sbi;
#pragma unroll
        for (int nt = 0; nt < 8; ++nt) {
            const f32x4 c = MFMA16(ua[sb], bfr[nt], ((f32x4){0.f, 0.f, 0.f, 0.f}));
#pragma unroll
            for (int i = 0; i < 4; ++i) bu[(4 * lq + i) * 132 + 16 * nt + l15] = c[i];
        }
        S5_WAVE_SYNC();
        for (int tt = 0; tt < 16; ++tt) {
            const int tl = dir ? 15 - tt : tt;
            const float br = bu[tl * 132 + lane], bi = bu[tl * 132 + 64 + lane];
            const float nr = A.x * hr - A.y * hi + br, ni = A.x * hi + A.y * hr + bi; hr = nr; hi = ni;
            if (WITH_C) { hb[tl * 136 + lane] = f2bf(hr); hb[tl * 136 + 64 + lane] = f2bf(hi); }
        }
        S5_WAVE_SYNC();
        if (WITH_C) {
            f32x4 a = (f32x4){0.f, 0.f, 0.f, 0.f};
#pragma unroll
            for (int s = 0; s < 4; ++s) { const bf16x8 af = *(const bf16x8*)(hb + l15 * 136 + 32 * s + 8 * lq); a = MFMA16(af, cf[s], a); }
            acc[sb] += a;
        }
    }
}
DI void s5_pass1_unit(const Params& p, int j, int unit, unsigned char* l) {
    const int gb = unit & 3, jc = (unit >> 2) % NCH, b = (unit >> 2) / NCH;
    const int tid = tidx(), w = tid >> 6, lane = tid & 63, g = gb * 8 + w, gp = g * 64 + lane;
    float2* E = (float2*)(p.ws + OFF_BIG + BE_S5E);
    const int rowbase = s5_rowbase(b, jc);
    f32x4 acc[4];
    __syncthreads();
#pragma unroll
    for (int dir = 0; dir < 2; ++dir) {
        float hr = 0.f, hi = 0.f;
        s5_dir<false>(p, j, dir, g, rowbase, hr, hi, acc, l + w * S5_WAVE);
        E[((size_t)(b * 2 + dir) * NCH + scan_idx(jc, dir)) * 2048 + gp] = make_float2(hr, hi);
    }
}
DI void s5_carry_scan(const Params& p, int j, int wg0) {
    const int nw = (int)gridDim.x - wg0;
    if ((int)blockIdx.x < wg0) return;
    for (int gt = ((int)blockIdx.x - wg0) * 512 + tidx(); gt < 8192; gt += nw * 512) {
    const int gp = gt & 2047, bd = gt >> 11, dir = bd & 1;
    float2* Ep = (float2*)(p.ws + OFF_BIG + BE_S5E) + (size_t)bd * NCH * 2048 + gp;
    const float2 A64 = ((const float2*)(p.ws + OFF_SA64))[(j * 2 + dir) * 2048 + gp];
    float hr = 0.f, hi = 0.f; asm volatile("" : "+v"(hr), "+v"(hi));
    for (int n0 = 0; n0 < NCH; n0 += 12) {
        float2 e[12];
#pragma unroll
        for (int i = 0; i < 12; ++i) e[i] = Ep[(size_t)(n0 + i) * 2048];
#pragma unroll
        for (int i = 0; i < 12; ++i) { Ep[(size_t)(n0 + i) * 2048] = make_float2(hr, hi);
            const float nr = A64.x * hr - A64.y * hi + e[i].x, ni = A64.x * hi + A64.y * hr + e[i].y; hr = nr; hi = ni; }
    }
    }
}
DI void s5_pass2_unit(const Params& p, int j, int unit, unsigned char* l) {
    const int gb = unit & 3, jc = (unit >> 2) % NCH, b = (unit >> 2) / NCH;
    const int tid = tidx(), w = tid >> 6, lane = tid & 63, g = gb * 8 + w, gp = g * 64 + lane;
    const u16* U = (const u16*)(p.ws + OFF_BIG + BE_U);
    const float2* E = (const float2*)(p.ws + OFF_BIG + BE_S5E);
    u16* Z = (u16*)(p.ws + OFF_BIG + BE_Z);
    const int rowbase = s5_rowbase(b, jc);
    f32x4 acc[4];
#pragma unroll
    for (int i = 0; i < 4; ++i) acc[i] = (f32x4){0.f, 0.f, 0.f, 0.f};
    __syncthreads();
#pragma unroll
    for (int dir = 0; dir < 2; ++dir) {
        const float2 h0 = E[((size_t)(b * 2 + dir) * NCH + scan_idx(jc, dir)) * 2048 + gp];
        float hr = h0.x, hi = h0.y;
        s5_dir<true>(p, j, dir, g, rowbase, hr, hi, acc, l + w * S5_WAVE);
    }
    const int col = g * 16 + (lane & 15);
    const float dcoef = p.in[20][j * 512 + col];
#pragma unroll
    for (int sb = 0; sb < 4; ++sb)
#pragma unroll
        for (int i = 0; i < 4; ++i) {
            const int t = sb * 16 + 4 * (lane >> 4) + i;
            const float y = acc[sb][i] + dcoef * bf2f(U[(size_t)(rowbase + t) * 512 + col]);
            Z[(size_t)(rowbase + t) * 512 + col] = f2bf(gelu_tanh(y));
        }
}

constexpr int GL_S136 = 136, GL_S72 = 72;
constexpr int GL_CUM = 0, GL_QT = 33792, GL_KT = GL_QT + 64 * 136 * 2, GL_QS = GL_KT + 64 * 136 * 2, GL_VT = GL_QS + 64 * 136 * 2, GL_ATT = GL_VT + 128 * 72 * 2, GL_KDT = GL_ATT + 64 * 72 * 2;
DI int gla_rowbase(int b, int jc) { return jc < 4 ? NLAT + b * 256 + jc * 64 : b * 8192 + (jc - 4) * 64; }
DI void ld16(const u16* p, float* f) {
    const u32x4 a = *(const u32x4*)p, b = *(const u32x4*)(p + 8);
    f[0] = bflo(a.x); f[1] = bfhi(a.x); f[2] = bflo(a.y); f[3] = bfhi(a.y); f[4] = bflo(a.z); f[5] = bfhi(a.z); f[6] = bflo(a.w); f[7] = bfhi(a.w);
    f[8] = bflo(b.x); f[9] = bfhi(b.x); f[10] = bflo(b.y); f[11] = bfhi(b.y); f[12] = bflo(b.z); f[13] = bfhi(b.z); f[14] = bflo(b.w); f[15] = bfhi(b.w);
}
DI void gla_cum(unsigned char* l, const u16* PROJ, const float* lbv, int mixer, int h, int dir, int rowbase, float* kv) {
    const int tid = tidx(), t = tid >> 3, d0 = (tid & 7) * 16;
    float* cum = (float*)(l + GL_CUM);
    const u16* prow = PROJ + (size_t)(rowbase + t) * 4608 + h * 128 + d0;
    if (mixer == 0) {
        const float lg = log1pf(-exp2f(-(5.f + 0.5f * dir) - (float)h));
        const float c = dir ? lg * (float)(64 - t) : lg * (float)(t + 1);
#pragma unroll
        for (int i = 0; i < 16; ++i) cum[t * 128 + d0 + i] = c;
        ld16(prow + 512, kv);
        __syncthreads();
    } else {
        float x[16]; ld16(prow + (dir ? 3072 : 2560), x);
#pragma unroll
        for (int i = 0; i < 16; ++i) { const float lbd = lbv[h * 128 + d0 + i]; const float f = lbd + (1.f - lbd) * sigmoidf_(x[i]); kv[i] = 1.f - f; cum[t * 128 + d0 + i] = __logf(f); }
        __syncthreads();
        { const int q = tid >> 7, d = tid & 127; float sacc = 0.f;
          if (dir == 0) { for (int r = 16 * q; r < 16 * q + 16; ++r) { sacc += cum[r * 128 + d]; cum[r * 128 + d] = sacc; } }
          else { for (int r = 16 * q + 15; r >= 16 * q; --r) { sacc += cum[r * 128 + d]; cum[r * 128 + d] = sacc; } }
          __syncthreads();
          float off = 0.f;
          if (dir == 0) { for (int qq = 0; qq < q; ++qq) off += cum[(16 * qq + 15) * 128 + d]; }
          else { for (int qq = q + 1; qq < 4; ++qq) off += cum[(16 * qq) * 128 + d]; }
          __syncthreads();
          for (int r = 16 * q; r < 16 * q + 16; ++r) cum[r * 128 + d] += off; }
        __syncthreads();
    }
}
DI void gla_load_vt(unsigned char* l, const u16* PROJ, int mixer, int h, int rowbase) {
    const int tid = tidx(), t = tid & 63, d0 = (tid >> 6) * 16;
    u16* vt = (u16*)(l + GL_VT);
    const u16* prow = PROJ + (size_t)(rowbase + t) * 4608 + (mixer ? 3584 : 1024) + h * 128 + d0;
    const u32x4 a = *(const u32x4*)prow, b = *(const u32x4*)(prow + 8);
    const unsigned wv[8] = {a.x, a.y, a.z, a.w, b.x, b.y, b.z, b.w};
#pragma unroll
    for (int i = 0; i < 8; ++i) { vt[(d0 + 2 * i) * GL_S72 + t] = (u16)(wv[i] & 0xffffu); vt[(d0 + 2 * i + 1) * GL_S72 + t] = (u16)(wv[i] >> 16); }
}
DI void gla_pass1_unit(const Params& p, int b, int lbj, int unit, unsigned char* l) {
    const int jc = unit % NCH, r0 = unit / NCH, dir = r0 & 1, h = (r0 >> 1) & 3, mixer = r0 >> 3;
    const u16* PROJ = (const u16*)(p.ws + OFF_BIG + BO_PROJ);
    u16* GST = (u16*)(p.ws + OFF_BIG + BO_GST); float* GDEC = (float*)(p.ws + OFF_GDEC);
    const float* lbv = (const float*)(p.ws + OFF_LB) + lbj * 512;
    const int tid = tidx(), t = tid >> 3, d0 = (tid & 7) * 16, rowbase = gla_rowbase(b, jc);
    const int n = scan_idx(jc, dir);
    const size_t seq = (size_t)((mixer * 4 + h) * 2 + dir) * NCH + n;
    __syncthreads();
    float kv[16];
    gla_cum(l, PROJ, lbv, mixer, h, dir, rowbase, kv);
    gla_load_vt(l, PROJ, mixer, h, rowbase);
    const float* cum = (const float*)(l + GL_CUM); u16* kdt = (u16*)(l + GL_KDT);
    const int te = dir ? 0 : 63;
#pragma unroll
    for (int i = 0; i < 16; ++i) { const float e = cum[te * 128 + d0 + i]; kdt[(d0 + i) * GL_S72 + t] = f2bf(kv[i] * __expf(e - cum[t * 128 + d0 + i])); }
    if (tid < 128) GDEC[seq * 128 + tid] = __expf(cum[te * 128 + tid]);
    __syncthreads();
    const int w = tid >> 6, lane = tid & 63, l31 = lane & 31, hh = lane >> 5, er = w >> 1;
    const u16* vt = (const u16*)(l + GL_VT);
#pragma unroll
    for (int q = 0; q < 2; ++q) {
        const int dc = (w & 1) * 2 + q;
        f32x16 a;
#pragma unroll
        for (int i = 0; i < 16; ++i) a[i] = 0.f;
#pragma unroll
        for (int ks = 0; ks < 4; ++ks) {
            const bf16x8 af = *(const bf16x8*)(vt + (32 * er + l31) * GL_S72 + 16 * ks + 8 * hh);
            const bf16x8 bf = *(const bf16x8*)(kdt + (32 * dc + l31) * GL_S72 + 16 * ks + 8 * hh);
            a = MFMA32(af, bf, a);
        }
        u16* dst = GST + seq * 16384;
#pragma unroll
        for (int i = 0; i < 16; ++i) dst[(32 * er + crow32(i, hh)) * 128 + 32 * dc + l31] = f2bf(a[i]);
    }
}
DI void gla_scan(const Params& p) {
    u16* GST = (u16*)(p.ws + OFF_BIG + BO_GST); const float* GDEC = (const float*)(p.ws + OFF_GDEC);
    for (int gt = blockIdx.x * 512 + tidx(); gt < 16 * 8192; gt += gridDim.x * 512) {
    const int sq = gt >> 13, idx = (gt & 8191) * 2, d = idx & 127;
    unsigned* base = (unsigned*)(GST + (size_t)sq * NCH * 16384 + idx); const float* dec = GDEC + (size_t)sq * NCH * 128 + d;
    float s0 = 0.f, s1 = 0.f; asm volatile("" : "+v"(s0), "+v"(s1));
    for (int n0 = 0; n0 < NCH; n0 += 12) {
        unsigned kv[12]; float2 dc[12];
#pragma unroll
        for (int i = 0; i < 12; ++i) { kv[i] = base[(size_t)(n0 + i) * 8192]; dc[i] = *(const float2*)(dec + (size_t)(n0 + i) * 128); }
#pragma unroll
        for (int i = 0; i < 12; ++i) { base[(size_t)(n0 + i) * 8192] = pk2(s0, s1);
            s0 = dc[i].x * s0 + bflo(kv[i]); s1 = dc[i].y * s1 + bfhi(kv[i]); }
    }
    }
}
DI void gla_pass3_unit(const Params& p, int b, int lbj, int jodd, int unit, unsigned char* l, bool latent_only) {
    const int nch = latent_only ? 128 : NCH;
    const int jc = latent_only ? 4 + unit % 128 : unit % NCH, r0 = unit / nch, h = r0 & 3, mixer = r0 >> 2;
    const u16* PROJ = (const u16*)(p.ws + OFF_BIG + BO_PROJ);
    const u16* GST = (const u16*)(p.ws + OFF_BIG + BO_GST);
    const float* lbv = (const float*)(p.ws + OFF_LB) + lbj * 512;
    u16* HB = (u16*)(p.ws + OFF_HB);
    const int tid = tidx(), t = tid >> 3, d0 = (tid & 7) * 16, rowbase = gla_rowbase(b, jc);
    const int w = tid >> 6, lane = tid & 63, l31 = lane & 31, hh = lane >> 5, tr = w >> 2, ec = w & 3;
    f32x16 oacc;
#pragma unroll
    for (int i = 0; i < 16; ++i) oacc[i] = 0.f;
    __syncthreads();
    gla_load_vt(l, PROJ, mixer, h, rowbase);
    float qv[16]; ld16(PROJ + (size_t)(rowbase + t) * 4608 + (mixer ? 2048 : 0) + h * 128 + d0, qv);
    for (int dir = 0; dir < 2; ++dir) {
        float kv[16];
        bf16x8 sfr[8];
        { const u16* S = GST + ((size_t)((mixer * 4 + h) * 2 + dir) * NCH + scan_idx(jc, dir)) * 16384 + (32 * ec + l31) * 128 + 8 * hh;
#pragma unroll
          for (int ks = 0; ks < 8; ++ks) sfr[ks] = *(const bf16x8*)(S + 16 * ks); }
        gla_cum(l, PROJ, lbv, mixer, h, dir, rowbase, kv);
        const float* cum = (const float*)(l + GL_CUM);
        u16* qt = (u16*)(l + GL_QT); u16* ktl = (u16*)(l + GL_KT); u16* qsl = (u16*)(l + GL_QS); u16* att = (u16*)(l + GL_ATT);
        const int tref = dir ? 32 : 31;
        {
            float fq_[16], fk_[16], fs_[16];
#pragma unroll
            for (int i = 0; i < 16; ++i) { const float c = cum[t * 128 + d0 + i], rf = cum[tref * 128 + d0 + i];
                fq_[i] = qv[i] * __expf(c - rf); fk_[i] = kv[i] * __expf(rf - c); fs_[i] = qv[i] * __expf(c); }
#pragma unroll
            for (int hf = 0; hf < 2; ++hf) { u32x4 wq, wk, ws;
                wq.x = pk2(fq_[8 * hf], fq_[8 * hf + 1]); wq.y = pk2(fq_[8 * hf + 2], fq_[8 * hf + 3]); wq.z = pk2(fq_[8 * hf + 4], fq_[8 * hf + 5]); wq.w = pk2(fq_[8 * hf + 6], fq_[8 * hf + 7]);
                wk.x = pk2(fk_[8 * hf], fk_[8 * hf + 1]); wk.y = pk2(fk_[8 * hf + 2], fk_[8 * hf + 3]); wk.z = pk2(fk_[8 * hf + 4], fk_[8 * hf + 5]); wk.w = pk2(fk_[8 * hf + 6], fk_[8 * hf + 7]);
                ws.x = pk2(fs_[8 * hf], fs_[8 * hf + 1]); ws.y = pk2(fs_[8 * hf + 2], fs_[8 * hf + 3]); ws.z = pk2(fs_[8 * hf + 4], fs_[8 * hf + 5]); ws.w = pk2(fs_[8 * hf + 6], fs_[8 * hf + 7]);
                *(u32x4*)(qt + t * GL_S136 + d0 + 8 * hf) = wq; *(u32x4*)(ktl + t * GL_S136 + d0 + 8 * hf) = wk; *(u32x4*)(qsl + t * GL_S136 + d0 + 8 * hf) = ws; }
        }
        __syncthreads();
        { const int tt = w >> 1;
#pragma unroll
          for (int q = 0; q < 2; ++q) { const int ts = (w & 1) * 2 + q;
            f32x4 a = (f32x4){0.f, 0.f, 0.f, 0.f};
#pragma unroll
            for (int ks = 0; ks < 4; ++ks) {
                const bf16x8 af = *(const bf16x8*)(qt + (16 * tt + (lane & 15)) * GL_S136 + 32 * ks + 8 * (lane >> 4));
                const bf16x8 bf = *(const bf16x8*)(ktl + (16 * ts + (lane & 15)) * GL_S136 + 32 * ks + 8 * (lane >> 4));
                a = MFMA16(af, bf, a); }
#pragma unroll
            for (int i = 0; i < 4; ++i) { const int trow = 16 * tt + 4 * (lane >> 4) + i, scol = 16 * ts + (lane & 15);
                const bool keep = dir ? (scol >= trow) : (scol <= trow);
                att[trow * GL_S72 + scol] = f2bf(keep ? a[i] : 0.f); } } }
        __syncthreads();
        const u16* vt = (const u16*)(l + GL_VT);
#pragma unroll
        for (int ks = 0; ks < 4; ++ks) {
            const bf16x8 af = *(const bf16x8*)(att + (32 * tr + l31) * GL_S72 + 16 * ks + 8 * hh);
            const bf16x8 bf = *(const bf16x8*)(vt + (32 * ec + l31) * GL_S72 + 16 * ks + 8 * hh);
            oacc = MFMA32(af, bf, oacc); }
#pragma unroll
        for (int ks = 0; ks < 8; ++ks) {
            const bf16x8 af = *(const bf16x8*)(qsl + (32 * tr + l31) * GL_S136 + 16 * ks + 8 * hh);
            oacc = MFMA32(af, sfr[ks], oacc); }
        __syncthreads();
    }
    float* ob = (float*)(l + GL_CUM);
#pragma unroll
    for (int i = 0; i < 16; ++i) ob[(32 * tr + crow32(i, hh)) * 132 + 32 * ec + l31] = oacc[i];
    __syncthreads();
    { float v[16]; float s = 0.f;
#pragma unroll
      for (int i = 0; i < 16; ++i) { v[i] = ob[t * 132 + d0 + i]; s += v[i]; }
      if (mixer == 0) { s += __shfl_xor(s, 1); s += __shfl_xor(s, 2); s += __shfl_xor(s, 4); const float mean = s * (1.f / 128.f);
#pragma unroll
          for (int i = 0; i < 16; ++i) v[i] -= mean; }
      float ss = 0.f;
#pragma unroll
      for (int i = 0; i < 16; ++i) ss += v[i] * v[i];
      ss += __shfl_xor(ss, 1); ss += __shfl_xor(ss, 2); ss += __shfl_xor(ss, 4);
      const float rstd = rsqrtf(ss * (1.f / 128.f) + EPS);
      const float* gn = (mixer ? p.in[30] : p.in[28]) + jodd * 512 + h * 128 + d0;
      float gt_[16]; ld16(PROJ + (size_t)(rowbase + t) * 4608 + (mixer ? 4096 : 1536) + h * 128 + d0, gt_);
      u32x4 o0, o1; float r[16];
#pragma unroll
      for (int i = 0; i < 16; ++i) r[i] = v[i] * rstd * gn[i] * siluf_(gt_[i]);
      o0.x = pk2(r[0], r[1]); o0.y = pk2(r[2], r[3]); o0.z = pk2(r[4], r[5]); o0.w = pk2(r[6], r[7]);
      o1.x = pk2(r[8], r[9]); o1.y = pk2(r[10], r[11]); o1.z = pk2(r[12], r[13]); o1.w = pk2(r[14], r[15]);
      u16* dst = HB + (size_t)(rowbase + t) * 1024 + mixer * 512 + h * 128 + d0;
      *(u32x4*)dst = o0; *(u32x4*)(dst + 8) = o1; }
}

#define XB_TMO      128
#define XB_XCNT(j)  (256  + 64 * (j))
#define XB_XSUB(j)  (1280 + 64 * (j))
#define XB_XGEN(j)  (2304 + 64 * (j))
#define XB_TOP      3328
#define XB_TOPGEN   3392
#define XCD_BAR_WORDS 3456
#define XB_SPIN_CAP (1u << 22)
DI unsigned xb_ld(unsigned* p)              { return __hip_atomic_load(p, __ATOMIC_RELAXED, __HIP_MEMORY_SCOPE_AGENT); }
DI unsigned xb_add(unsigned* p, unsigned v) { return __hip_atomic_fetch_add(p, v, __ATOMIC_RELAXED, __HIP_MEMORY_SCOPE_AGENT); }
DI unsigned xb_xcc_id() { return (unsigned)__builtin_amdgcn_s_getreg((3 << 11) | 20) & 0xFu; }
#define XB_SPIN(cond, bar) do { unsigned _sp = 0; while (cond) { __builtin_amdgcn_s_sleep(1); \
    if ((++_sp & 255u) == 0u) { if (xb_ld(&(bar)[XB_TMO])) break; if (_sp > XB_SPIN_CAP) { atomicAdd(&(bar)[XB_TMO], 1u); break; } } } } while (0)
struct XcdBarrier { unsigned* bar; unsigned x; volatile LAS unsigned* st; };
DI XcdBarrier xcd_barrier_post(unsigned* bar, volatile LAS unsigned* st) {
    XcdBarrier b; b.bar = bar; b.x = xb_xcc_id(); b.st = st;
    if (threadIdx.x == 0) (void)xb_add(&bar[XB_XCNT(b.x)], 1u);
    return b;
}
DI void xcd_barrier_complete(unsigned* bar, unsigned x, unsigned& nloc, unsigned& nx) {
    const unsigned G = gridDim.x * gridDim.y * gridDim.z;
    unsigned sum, cnt, mine, sp = 0u;
    for (;;) {
        sum = 0u; cnt = 0u; mine = 0u;
#pragma unroll
        for (unsigned j = 0; j < 16; ++j) { const unsigned c = xb_ld(&bar[XB_XCNT(j)]); sum += c; cnt += (c > 0u) ? 1u : 0u; mine = (j == x) ? c : mine; }
        if (sum == G) break;
        __builtin_amdgcn_s_sleep(1);
        if ((++sp & 255u) == 0u) { if (xb_ld(&bar[XB_TMO])) break; if (sp > XB_SPIN_CAP) { atomicAdd(&bar[XB_TMO], 1u); break; } }
    }
    nloc = mine > 0u ? mine : 1u; nx = cnt > 0u ? cnt : 1u;
}
DI void xcd_barrier(const XcdBarrier& b) {
    asm volatile("s_waitcnt vmcnt(0)" ::: "memory");
    __syncthreads();
    if (threadIdx.x == 0) {
        unsigned* bar = b.bar;
        __builtin_amdgcn_s_waitcnt(0);
        unsigned nloc = b.st[0], nx = b.st[1];
        if (nloc == 0u) { xcd_barrier_complete(bar, b.x, nloc, nx); b.st[0] = nloc; b.st[1] = nx; }
        const unsigned old = xb_add(&bar[XB_XSUB(b.x)], 1u);
        const unsigned gen = old / nloc;
        if (old + 1u == (gen + 1u) * nloc) {
            __builtin_amdgcn_fence(__ATOMIC_RELEASE, "agent");
            asm volatile("s_waitcnt vmcnt(0)" ::: "memory");
            const unsigned og = xb_add(&bar[XB_TOP], 1u);
            const unsigned tg = og / nx;
            if (og + 1u == (tg + 1u) * nx) xb_add(&bar[XB_TOPGEN], 1u);
            else XB_SPIN(xb_ld(&bar[XB_TOPGEN]) == tg, bar);
            __builtin_amdgcn_fence(__ATOMIC_ACQUIRE, "agent");
            xb_add(&bar[XB_XGEN(b.x)], 1u);
            asm volatile("s_waitcnt vmcnt(0)" ::: "memory");
        } else {
            XB_SPIN(xb_ld(&bar[XB_XGEN(b.x)]) == gen, bar);
            __builtin_amdgcn_fence(__ATOMIC_ACQUIRE, "agent");
            asm volatile("s_waitcnt vmcnt(0)" ::: "memory");
        }
    }
    __syncthreads();
}

__global__ void __launch_bounds__(512) fwd_megakernel(Params p0) {
    Params p = p0;
    extern __shared__ __attribute__((aligned(16))) unsigned char lds_raw[];
    LAS unsigned char* lds = (LAS unsigned char*)lds_raw;
    cg::grid_group grid = cg::this_grid();
    volatile LAS unsigned* xst = (volatile LAS unsigned*)(lds + 147440);
    if (threadIdx.x < 4) xst[threadIdx.x] = 0u;
    __syncthreads();
    const XcdBarrier xb = xcd_barrier_post((unsigned*)(p.ws + OFF_BAR), xst);
#define GSYNC() do { for (int r_ = 0; r_ < REP(1); ++r_) xcd_barrier(xb); } while (0)
    unsigned char* ws = p.ws;
    float* mod = (float*)(ws + OFF_MOD);
    float* XRES = (float*)(ws + OFF_XRES);
    u16* HB = (u16*)(ws + OFF_HB);
    unsigned char* BIG = ws + OFF_BIG;
    const int G = gridDim.x, bid = blockIdx.x;

    for (int r_ = 0; r_ < REP(32); ++r_) prep_phase(p, (float*)lds_raw);
    if (p.ws == nullptr) grid.sync();
    GSYNC();
    { const float* mp = (const float*)(p.ws + OFF_MODP); float* md = (float*)(p.ws + OFF_MOD);
      for (int i = bid * 512 + tidx(); i < 4 * 3 * 6144; i += G * 512) { float a = 0.f;
#pragma unroll
        for (int k = 0; k < 16; ++k) a += mp[(size_t)k * (4 * 3 * 6144) + i];
        md[i] = a; } }
    GSYNC();

    for (int li = 0; li < 4; ++li) {
        asm volatile("" : "+s"(p.ws));
        ws = p.ws; mod = (float*)(ws + OFF_MOD); XRES = (float*)(ws + OFF_XRES); HB = (u16*)(ws + OFF_HB); BIG = ws + OFF_BIG;
        const float* srcLat = li == 0 ? p.in[0] : XRES;
        const float* srcCtx = li == 0 ? p.in[2] : XRES + (size_t)NLAT * 1024;
        const float* modl = mod + li * 3 * 6144;
        const int j = li >> 1;
        for (int r_ = 0; r_ < REP(16); ++r_) { norm_rows(srcLat, srcCtx, p.in[6] + li * 1024, modl, 1024, 0, HB, li > 0 ? (float*)(BIG + 150000000) : nullptr, 11, mod + (li - 1) * 3 * 6144 + 2 * 6144 + 5 * 1024, XRES);
        conv_ffn_weights(p, li, (float*)lds_raw); }
        GSYNC();
        if ((li & 1) == 0) {
            float* ssq = (float*)(ws + OFF_SSQ); float* sskv = ssq + (size_t)NTOK * 8;
            u16* U = (u16*)(BIG + BE_U); u16* CQKV = (u16*)(BIG + BE_CQKV); u16* Q = (u16*)(BIG + BE_Q); u16* KC = (u16*)(BIG + BE_KC); u16* VT = (u16*)(BIG + BE_VT); u16* Z = (u16*)(BIG + BE_Z);
            { EpiInEven E{U, CQKV, KC, ssq, sskv, (const float*)(ws + OFF_RMLA)};
              run_gemm(lds, HB, 1024, (const u16*)(ws + OFF_WMIX + WE_IN), 1024, NTOK, 1024, 1024, E);
              if (REP(2) > 1) { EpiInEven E2{U, CQKV, KC, (float*)(BIG + 150000000), (float*)(BIG + 150000000), (const float*)(ws + OFF_RMLA)}; run_gemm(lds, HB, 1024, (const u16*)(ws + OFF_WMIX + WE_IN), 1024, NTOK, 1024, 1024, E2); } }
            GSYNC();
            for (int r_ = 0; r_ < REP(8); ++r_) for (int u = bid; u < 2 * NCH * 4; u += G) s5_pass1_unit(p, j, u, lds_raw);
            GSYNC();
            s5_carry_scan(p, j, G > 16 ? G - 16 : 0);
            { EpiQ E{Q, ssq, (const float*)(ws + OFF_RMLA)};
              for (int r_ = 0; r_ < REP(2); ++r_) run_gemm(lds, CQKV, 384, (const u16*)(ws + OFF_WMIX + WE_UQ), 256, NTOK, 768, 256, E); }
            { EpiKV E{KC, VT, sskv};
              for (int r_ = 0; r_ < REP(2); ++r_) run_gemm(lds, CQKV + 128, 384, (const u16*)(ws + OFF_WMIX + WE_UKV), 256, NTOK, 1024, 256, E); }
            GSYNC();
            for (int r_ = 0; r_ < 2; ++r_) for (int u = bid; u < 272 + 1056; u += G) {
                if (r_ == 1 && !(u < 272 ? REP(4) > 1 : REP(8) > 1)) continue;
                if (u < 256) { const int bh = (u & 7) * 2 + (u >> 7), qb = (u >> 3) & 15;
                    __syncthreads();
                    attn_unit64(lds, Q + ((size_t)bh * SEQ + qb * 512) * 96, KC + (size_t)bh * LK * 96, VT + (size_t)bh * 64 * LK, LK / 64,
                                HB + (size_t)((bh >> 3) * SEQ + qb * 512) * 1024 + 512 + (bh & 7) * 64);
                } else if (u < 272) { const int bh = u - 256;
                    __syncthreads();
                    attn_unit(lds, Q + (size_t)NLAT * 768 + (size_t)bh * CTXL * 96, KC + (size_t)bh * LK * 96, VT + (size_t)bh * 64 * LK, CTXL / 64,
                              HB + (size_t)(NLAT + (bh >> 3) * CTXL) * 1024 + 512 + (bh & 7) * 64);
                } else s5_pass2_unit(p, j, u - 272, lds_raw);
            }
            GSYNC();
            { EpiGlu E{Z, HB};
              for (int r_ = 0; r_ < REP(2); ++r_) run_gemm(lds, Z, 512, (const u16*)(ws + OFF_WMIX + WE_GLU), 512, NTOK, 512, 512, E); }
            GSYNC();
            { EpiRes E{srcLat, srcCtx, modl + 2048, XRES, (float*)(BIG + 150000000)};
              run_gemm_mixed(lds, HB, 1024, (const u16*)(ws + OFF_WMIX + WE_OUT), 1024, 1024, 1024, E);
              if (REP(2) > 1) { EpiRes E2{srcLat, srcCtx, modl + 2048, (float*)(BIG + 150000000), (float*)(BIG + 150000000)}; run_gemm(lds, HB, 1024, (const u16*)(ws + OFF_WMIX + WE_OUT), 1024, NTOK, 1024, 1024, E2); } }
            GSYNC();
        } else {
            u16* PROJ = (u16*)(BIG + BO_PROJ);
            { EpiInOdd E{PROJ, (const float*)(ws + OFF_RRET)};
              for (int r_ = 0; r_ < REP(2); ++r_) run_gemm(lds, HB, 1024, (const u16*)(ws + OFF_WMIX + WO_IN), 1024, NTOK, 4608, 1024, E); }
            GSYNC();
            for (int b = 0; b < 2; ++b) {
                for (int r_ = 0; r_ < REP(64); ++r_) for (int u = bid; u < 16 * NCH; u += G) gla_pass1_unit(p, b, j, u, lds_raw);
                GSYNC();
                gla_scan(p);
                GSYNC();
                for (int r_ = 0; r_ < REP(128); ++r_) for (int u = bid; u < 8 * (li == 3 ? 128 : NCH); u += G) gla_pass3_unit(p, b, j, j, u, lds_raw, li == 3);
                GSYNC();
            }
            { EpiRes E{srcLat, srcCtx, modl + 2048, XRES, (float*)(BIG + 150000000)};
              { if (li == 3) run_gemm(lds, HB, 1024, (const u16*)(ws + OFF_WMIX + WO_OUT), 1024, NLAT, 1024, 1024, E); else run_gemm_mixed(lds, HB, 1024, (const u16*)(ws + OFF_WMIX + WO_OUT), 1024, 1024, 1024, E); }
              if (REP(2) > 1) { EpiRes E2{srcLat, srcCtx, modl + 2048, (float*)(BIG + 150000000), (float*)(BIG + 150000000)}; run_gemm(lds, HB, 1024, (const u16*)(ws + OFF_WMIX + WO_OUT), 1024, NTOK, 1024, 1024, E2); } }
            GSYNC();
        }
        for (int r_ = 0; r_ < REP(16); ++r_) { norm_rows(XRES, srcCtx, p.in[7] + li * 1024, modl, 4 * 1024, 3 * 1024, HB, li < 3 ? (float*)(BIG + 150000000) : nullptr, 4, modl + 2 * 6144 + 2048, XRES);
        if (li < 3) conv_mixer_weights(p, li + 1, (float*)lds_raw); }
        GSYNC();
        { EpiFFN1 E{(u16*)(BIG)};
          for (int r_ = 0; r_ < REP(2); ++r_) { if (li == 3) run_gemm(lds, HB, 1024, (const u16*)(ws + OFF_WFFN + WF_13), 1024, NLAT, 5632, 1024, E); else run_gemm(lds, HB, 1024, (const u16*)(ws + OFF_WFFN + WF_13), 1024, NTOK, 5632, 1024, E); } }
        GSYNC();
        { EpiRes E{XRES, XRES + (size_t)NLAT * 1024, modl + 5 * 1024, XRES, (float*)(BIG + 150000000)};
          { if (li == 3) run_gemm(lds, (const u16*)BIG, DFF, (const u16*)(ws + OFF_WFFN + WF_2), DFF, NLAT, 1024, DFF, E); else run_gemm_mixed(lds, (const u16*)BIG, DFF, (const u16*)(ws + OFF_WFFN + WF_2), DFF, 1024, DFF, E); }
          if (REP(2) > 1) { EpiRes E2{XRES, XRES + (size_t)NLAT * 1024, modl + 5 * 1024, (float*)(BIG + 150000000), (float*)(BIG + 150000000)}; run_gemm(lds, (const u16*)BIG, DFF, (const u16*)(ws + OFF_WFFN + WF_2), DFF, NTOK, 1024, DFF, E2); } }
        GSYNC();
    }
    final_norm_rows(XRES, p.in[31], p.out);
}

extern "C" void kernel_launch(void* const* d_in, const int* in_sizes, int n_in, void* d_out, int out_size,
                              void* d_ws, size_t ws_size, hipStream_t stream) {
    constexpr size_t kDynLds = 147456;
    static int grid_blocks = 0;
    if (!grid_blocks) {
        int dev = 0, cus = 0, per_cu = 0;
        (void)hipGetDevice(&dev);
        (void)hipDeviceGetAttribute(&cus, hipDeviceAttributeMultiprocessorCount, dev);
        (void)hipFuncSetAttribute((const void*)fwd_megakernel, hipFuncAttributeMaxDynamicSharedMemorySize, (int)kDynLds);
        (void)hipOccupancyMaxActiveBlocksPerMultiprocessor(&per_cu, fwd_megakernel, 512, kDynLds);
        if (per_cu > 1) per_cu = 1;
        grid_blocks = cus * per_cu;
        if (ws_size < WS_NEED) fprintf(stderr, "workspace too small: %zu < %zu\n", ws_size, (size_t)WS_NEED);
    }
    Params p{};
    for (int i = 0; i < 32; ++i) p.in[i] = (const float*)d_in[i];
    p.out = (float*)d_out; p.ws = (unsigned char*)d_ws;
    (void)hipMemsetAsync((unsigned char*)d_ws + OFF_BAR, 0, 16384, stream);
    void* args[] = {&p};
    hipError_t e = hipLaunchCooperativeKernel((void*)fwd_megakernel, dim3(grid_blocks), dim3(512), args, kDynLds, stream);
    if (e != hipSuccess) fprintf(stderr, "cooperative launch failed: %s (grid %d)\n", hipGetErrorString(e), grid_blocks);
}
```

```cpp
#include <hip/hip_runtime.h>
#include <hip/hip_cooperative_groups.h>
#include <cstdio>
namespace cg = cooperative_groups;
#ifndef PROBE
#define PROBE 0
#endif
#define REP(mask) ((PROBE & (mask)) ? 2 : 1)
#define DI __device__ __forceinline__
#define LAS __attribute__((address_space(3)))
typedef unsigned short u16;
typedef short bf16x8 __attribute__((ext_vector_type(8)));
typedef float f32x4 __attribute__((ext_vector_type(4)));
typedef float f32x16 __attribute__((ext_vector_type(16)));
typedef unsigned u32x4 __attribute__((ext_vector_type(4)));
typedef unsigned u32x2 __attribute__((ext_vector_type(2)));

constexpr int DM = 1024, SEQ = 8192, CTXL = 256, NLAT = 16384, NCTX = 512, NTOK = 16896, DFF = 2816, LK = 8448;
constexpr int NCH = 132;
constexpr float EPS = 1e-6f;

constexpr size_t al256(size_t x) { return (x + 255) & ~(size_t)255; }
constexpr size_t OFF_MOD = 0;
constexpr size_t OFF_RMLA = al256(OFF_MOD + 4 * 3 * 6144 * 4);
constexpr size_t OFF_RRET = al256(OFF_RMLA + 8192 * 16 * 2 * 4);
constexpr size_t OFF_LB = al256(OFF_RRET + 8192 * 64 * 2 * 4);
constexpr size_t OFF_SAB = al256(OFF_LB + 2 * 512 * 4);
constexpr size_t OFF_SA64 = al256(OFF_SAB + 2 * 2 * 2048 * 8);
constexpr size_t OFF_SBB = al256(OFF_SA64 + 2 * 2 * 2048 * 8);
constexpr size_t OFF_SCC = al256(OFF_SBB + 2 * 2 * 2048 * 16 * 8);
constexpr size_t OFF_SSQ = al256(OFF_SCC + 2 * 2 * 32 * 16 * 128 * 2);
constexpr size_t OFF_GDEC = al256(OFF_SSQ + (size_t)NTOK * 12 * 4);
constexpr size_t OFF_WMIX = al256(OFF_GDEC + 2 * 4 * 2 * NCH * 128 * 4);
constexpr size_t WMIX_BYTES = 9437184 + 2097152;
constexpr size_t OFF_WFFN = al256(OFF_WMIX + WMIX_BYTES);
constexpr size_t WFFN_BYTES = (size_t)5632 * 1024 * 2 + (size_t)1024 * 2816 * 2;
constexpr size_t OFF_XRES = al256(OFF_WFFN + WFFN_BYTES);
constexpr size_t OFF_HB = al256(OFF_XRES + (size_t)NTOK * 1024 * 4);
constexpr size_t OFF_BIG = al256(OFF_HB + (size_t)NTOK * 1024 * 2);
constexpr size_t BE_U = 0;
constexpr size_t BE_CQKV = al256(BE_U + (size_t)NTOK * 512 * 2);
constexpr size_t BE_Q = al256(BE_CQKV + (size_t)NTOK * 384 * 2);
constexpr size_t BE_KC = al256(BE_Q + (size_t)NTOK * 768 * 2);
constexpr size_t BE_VT = al256(BE_KC + (size_t)2 * 8 * LK * 96 * 2);
constexpr size_t BE_Z = al256(BE_VT + (size_t)2 * 8 * 64 * LK * 2);
constexpr size_t BE_S5E = al256(BE_Z + (size_t)NTOK * 512 * 2);
constexpr size_t BO_PROJ = 0;
constexpr size_t BO_GST = al256(BO_PROJ + (size_t)NTOK * 4608 * 2);
constexpr size_t BIG_BYTES = BO_GST + (size_t)2 * 4 * 2 * NCH * 16384 * 2;
constexpr size_t OFF_BAR = al256(OFF_BIG + BIG_BYTES);
constexpr size_t OFF_MODP = OFF_BAR + 16384;
constexpr size_t WS_NEED = OFF_MODP + (size_t)16 * 4 * 3 * 6144 * 4;
constexpr size_t WE_IN = 0, WE_OUT = 2097152, WE_GLU = 4194304, WE_UQ = 4718592, WE_UKV = 5242880;
constexpr size_t WO_IN = 0, WO_OUT = 9437184;
constexpr size_t WF_13 = 0, WF_2 = (size_t)5632 * 1024 * 2;

struct Params { const float* in[32]; float* out; unsigned char* ws; };

DI int tidx() { int t = threadIdx.x; asm volatile("" : "+v"(t)); return t; }
typedef float f32x2 __attribute__((ext_vector_type(2)));
typedef __bf16 bf16x2_t __attribute__((ext_vector_type(2)));
DI unsigned pk2(float lo, float hi) { const f32x2 v = {lo, hi}; const bf16x2_t b = __builtin_convertvector(v, bf16x2_t); return __builtin_bit_cast(unsigned, b); }
DI u16 f2bf(float x) { return (u16)(pk2(x, x) & 0xffffu); }
DI float bf2f(u16 b) { return __uint_as_float(((unsigned)b) << 16); }
DI float bflo(unsigned w) { return __uint_as_float(w << 16); }
DI float bfhi(unsigned w) { return __uint_as_float(w & 0xffff0000u); }
DI float sigmoidf_(float x) { return 1.f / (1.f + __expf(-x)); }
DI float siluf_(float x) { return x / (1.f + __expf(-x)); }
DI float gelu_tanh(float y) { float t = 0.7978845608028654f * (y + 0.044715f * y * y * y); return 0.5f * y * (1.f + tanhf(t)); }
DI int tok_b(int row) { return row < NLAT ? (row >> 13) : ((row - NLAT) >> 8); }
DI int tok_bidx(int row) { return row < NLAT ? (row >> 13) : 2; }
#define MFMA32(a, b, c) __builtin_amdgcn_mfma_f32_32x32x16_bf16((a), (b), (c), 0, 0, 0)
#define MFMA16(a, b, c) __builtin_amdgcn_mfma_f32_16x16x32_bf16((a), (b), (c), 0, 0, 0)
DI int scan_idx(int jc, int dir) { return dir ? (jc < 4 ? 3 - jc : 135 - jc) : jc; }
DI int crow32(int i, int hh) { return (i & 3) + 8 * (i >> 2) + 4 * hh; }

namespace pg8 {
constexpr int BM = 256, BK = 64, HALF = 128, HTB = HALF * BK * 2, NXCD = 8, WGM = 8;
DI int lds_byte(int r, int c) { const int st = (r >> 4) * 2 + (c >> 5), rr = r & 15, cc = c & 31, ob = rr * 64 + cc * 2; return st * 1024 + (ob ^ (((ob >> 9) & 1) << 5)); }
DI void stage_rc(int b, int& R, int& C) { const int st = b / 1024, sb = b % 1024, swz = sb ^ (((sb >> 9) & 1) << 5); R = (st >> 1) * 16 + swz / 64; C = (st & 1) * 32 + (swz % 64) / 2; }
struct Unit { int pm, pn, ks; };
struct Gemm { const u16* A; const u16* Bt; int M, N, K, lda, ldb; };
struct StaticOrder {
    int nM, nN, nwg, G, c;
    DI void init(int M, int N, int G_, int c_) { nM = M / BM; nN = N / BM; nwg = nM * nN; G = G_; c = c_; }
    DI bool next(int i, Unit& u) const {
        const long L = (long)i * G + c; if (L >= nwg) return false;
        int wgid = (int)L; { const int q = nwg / NXCD, r = nwg % NXCD, xcd = wgid % NXCD, off = wgid / NXCD; wgid = (xcd < r ? xcd * (q + 1) : r * (q + 1) + (xcd - r) * q) + off; }
        const int nig = WGM * nN, gid = wgid / nig, fm = gid * WGM, gsz = (nM - fm) < WGM ? (nM - fm) : WGM;
        u.pm = fm + ((wgid % nig) % gsz); u.pn = (wgid % nig) / gsz; u.ks = -1; return true;
    }
};
struct MixedOrder {
    StaticOrder lat; int nN, KS, nlat, ntot;
    DI void init(int N, int KS_, int G_, int c_) { lat.init(16384, N, G_, c_); nN = N / BM; KS = KS_; nlat = lat.nwg; ntot = nlat + 2 * nN * KS; }
    DI bool next(int i, Unit& u) const {
        const long L = (long)i * lat.G + lat.c; if (L >= ntot) return false;
        if (L < nlat) return lat.next(i, u);
        const int e = (int)L - nlat, r = e / KS; u.ks = e - r * KS; u.pn = r % nN; u.pm = 64 + r / nN; return true;
    }
};
template <class Epi, class Sched>
DI void gemm_phase(LAS unsigned char* lds, const Gemm g, const Sched& S, const Epi& E) {
    const int tid = tidx(), wid = __builtin_amdgcn_readfirstlane(tid >> 6), lane = tid & 63, wr = wid >> 2, wc = wid & 3, fr = lane & 15, fq = lane >> 4;
    int K = g.K; asm volatile("" : "+s"(K)); const int ntFull = K / BK;
    unsigned voffA[2], voffB[2];
#pragma unroll
    for (int i = 0; i < 2; ++i) { int R, C; stage_rc(tid * 16 + i * 8192, R, C);
        voffA[i] = (unsigned)(R * g.lda + C) * 2u; voffB[i] = (unsigned)(R * g.ldb + C) * 2u; }
    const size_t kstep = (size_t)(BK * 2);
    const size_t hstepA = (size_t)HALF * g.lda * 2, hstepB = (size_t)HALF * g.ldb * 2;
    const size_t tstepA = 2 * hstepA, tstepB = 2 * hstepB;
    const unsigned ldsw = (unsigned)wid * 1024u;
    const int aoff = lds_byte(wr * 64 + fr, fq * 8), boff = lds_byte(wc * 32 + fr, fq * 8);
#define PG8_SA(b, h) (((b) * 2 + (h)) * HTB)
#define PG8_SB(b, h) ((4 + (b) * 2 + (h)) * HTB)
#define PG8_STAGE(bufoff, gbase, voff) do { _Pragma("unroll") for (int _i = 0; _i < 2; ++_i) \
        __builtin_amdgcn_global_load_lds((const unsigned*)((const char*)(gbase) + (voff)[_i]), (LAS unsigned*)(lds + (bufoff) + ldsw + _i * 8192), 16, 0, 0); } while (0)
#define PG8_LDA(dst, b, h) do { _Pragma("unroll") for (int m = 0; m < 4; ++m) _Pragma("unroll") for (int k = 0; k < 2; ++k) dst[m][k] = *(const LAS bf16x8*)(lds + PG8_SA(b, h) + aoff + m * 2048 + k * 1024); } while (0)
#define PG8_LDB(dst, b, h) do { _Pragma("unroll") for (int n = 0; n < 2; ++n) _Pragma("unroll") for (int k = 0; k < 2; ++k) dst[n][k] = *(const LAS bf16x8*)(lds + PG8_SB(b, h) + boff + n * 2048 + k * 1024); } while (0)
#define PG8_MMA(ai, bj, At, Bt) do { __builtin_amdgcn_s_setprio(1); _Pragma("unroll") for (int m = 0; m < 4; ++m) _Pragma("unroll") for (int n = 0; n < 2; ++n) _Pragma("unroll") for (int k = 0; k < 2; ++k) \
        acc[ai][bj][m][n] = __builtin_amdgcn_mfma_f32_16x16x32_bf16(Bt[n][k], At[m][k], acc[ai][bj][m][n], 0, 0, 0); __builtin_amdgcn_s_setprio(0); } while (0)
#define PG8_WAIT_V(n) asm volatile("s_waitcnt vmcnt(" #n ")" ::: "memory")
#define PG8_WAIT_L(n) asm volatile("s_waitcnt lgkmcnt(" #n ")" ::: "memory")
#define PG8_BAR __builtin_amdgcn_s_barrier()
#define PG8_SCHED __builtin_amdgcn_sched_barrier(0)
    Unit cur, nxt; int ui = 0;
    if (!S.next(0, cur)) return;
    f32x4 acc[2][2][4][2];
#pragma unroll
    for (int a = 0; a < 2; ++a)
#pragma unroll
        for (int b = 0; b < 2; ++b)
#pragma unroll
            for (int m = 0; m < 4; ++m)
#pragma unroll
                for (int n = 0; n < 2; ++n) acc[a][b][m][n] = (f32x4){0.f, 0.f, 0.f, 0.f};
    bf16x8 At[4][2], B0[2][2], B1[2][2];
    const char* cA = (const char*)g.A + (size_t)cur.pm * tstepA + (cur.ks >= 0 ? cur.ks * 512 : 0); const char* cB = (const char*)g.Bt + (size_t)cur.pn * tstepB + (cur.ks >= 0 ? cur.ks * 512 : 0);
    int nt = cur.ks >= 0 ? 4 : ntFull;
    PG8_STAGE(PG8_SB(0, 0), cB, voffB); PG8_STAGE(PG8_SA(0, 0), cA, voffA); PG8_STAGE(PG8_SB(0, 1), cB + hstepB, voffB); PG8_STAGE(PG8_SA(0, 1), cA + hstepA, voffA);
    if (wr == 1) PG8_BAR;
    PG8_WAIT_V(4); PG8_BAR;
    PG8_STAGE(PG8_SB(1, 0), cB + kstep, voffB); PG8_STAGE(PG8_SA(1, 0), cA + kstep, voffA); PG8_STAGE(PG8_SB(1, 1), cB + hstepB + kstep, voffB);
    PG8_WAIT_V(6); PG8_BAR;
    for (;;) {
        const bool has_next = S.next(ui + 1, nxt);
        const char* nA = has_next ? (const char*)g.A + (size_t)nxt.pm * tstepA + (nxt.ks >= 0 ? nxt.ks * 512 : 0) : cA; const char* nB = has_next ? (const char*)g.Bt + (size_t)nxt.pn * tstepB + (nxt.ks >= 0 ? nxt.ks * 512 : 0) : cB;
        for (int t = 0; t < nt; t += 2) {
            const bool last = (t == nt - 2);
            const char* a1 = cA + (size_t)(t + 1) * kstep;
            const char* a2 = last ? nA : cA + (size_t)(t + 2) * kstep; const char* b2 = last ? nB : cB + (size_t)(t + 2) * kstep;
            const char* a3 = a2 + kstep; const char* b3 = b2 + kstep;
            PG8_LDB(B0, 0, 0); PG8_SCHED; PG8_LDA(At, 0, 0); PG8_STAGE(PG8_SA(1, 1), a1 + hstepA, voffA);
            PG8_WAIT_L(8); PG8_BAR; PG8_WAIT_L(0); PG8_MMA(0, 0, At, B0); PG8_BAR; PG8_SCHED;
            PG8_LDB(B1, 0, 1); PG8_STAGE(PG8_SB(0, 0), b2, voffB);
            PG8_BAR; PG8_WAIT_L(0); PG8_MMA(0, 1, At, B1); PG8_BAR;
            PG8_LDA(At, 0, 1); PG8_STAGE(PG8_SA(0, 0), a2, voffA);
            PG8_BAR; PG8_WAIT_L(0); PG8_MMA(1, 0, At, B0); PG8_BAR; PG8_SCHED;
            PG8_STAGE(PG8_SB(0, 1), b2 + hstepB, voffB);
            PG8_WAIT_V(6); PG8_BAR; PG8_MMA(1, 1, At, B1); PG8_BAR;
            PG8_LDB(B0, 1, 0); PG8_SCHED; PG8_LDA(At, 1, 0); PG8_STAGE(PG8_SA(0, 1), a2 + hstepA, voffA);
            PG8_WAIT_L(8); PG8_BAR; PG8_WAIT_L(0); PG8_MMA(0, 0, At, B0); PG8_BAR; PG8_SCHED;
            PG8_LDB(B1, 1, 1); PG8_STAGE(PG8_SB(1, 0), b3, voffB);
            PG8_BAR; PG8_WAIT_L(0); PG8_MMA(0, 1, At, B1); PG8_BAR;
            PG8_LDA(At, 1, 1); PG8_STAGE(PG8_SA(1, 0), a3, voffA);
            PG8_BAR; PG8_WAIT_L(0); PG8_MMA(1, 0, At, B0); PG8_BAR; PG8_SCHED;
            PG8_STAGE(PG8_SB(1, 1), b3 + hstepB, voffB);
            PG8_WAIT_V(6); PG8_BAR; PG8_MMA(1, 1, At, B1); PG8_BAR;
        }
        { int fr2 = fr, fq2 = fq; asm volatile("" : "+v"(fr2), "+v"(fq2)); E(acc, cur, wr, wc, fr2, fq2); }
        if (!has_next) break;
#pragma unroll
        for (int a = 0; a < 2; ++a)
#pragma unroll
            for (int b = 0; b < 2; ++b)
#pragma unroll
                for (int m = 0; m < 4; ++m)
#pragma unroll
                    for (int n = 0; n < 2; ++n) acc[a][b][m][n] = (f32x4){0.f, 0.f, 0.f, 0.f};
        cur = nxt; cA = nA; cB = nB; ++ui; nt = cur.ks >= 0 ? 4 : ntFull;
    }
    PG8_WAIT_V(0);
    if (wr == 0) PG8_BAR;
    PG8_BAR;
#undef PG8_SA
#undef PG8_SB
#undef PG8_STAGE
#undef PG8_LDA
#undef PG8_LDB
#undef PG8_MMA
#undef PG8_WAIT_V
#undef PG8_WAIT_L
#undef PG8_BAR
#undef PG8_SCHED
}
}
using pg8::Unit;
typedef f32x4 AccT[2][2][4][2];
#define EPI_ROW(u, ai, m) ((u).pm * 256 + (ai) * 128 + wr * 64 + (m) * 16 + fr)
#define EPI_COLBASE(u, bj) ((u).pn * 256 + (bj) * 128 + wc * 32)

template <class Epi>
DI void run_gemm(LAS unsigned char* lds, const u16* A, int lda, const u16* Bt, int ldb, int M, int N, int K, const Epi& E) {
    pg8::Gemm g; g.A = A; g.Bt = Bt; g.M = M; g.N = N; g.K = K; g.lda = lda; g.ldb = ldb;
    pg8::StaticOrder S; S.init(M, N, (int)gridDim.x, (int)blockIdx.x);
    pg8::gemm_phase<Epi, pg8::StaticOrder>(lds, g, S, E);
    __syncthreads();
}
template <class Epi>
DI void run_gemm_mixed(LAS unsigned char* lds, const u16* A, int lda, const u16* Bt, int ldb, int N, int K, const Epi& E) {
    pg8::Gemm g; g.A = A; g.Bt = Bt; g.M = NTOK; g.N = N; g.K = K; g.lda = lda; g.ldb = ldb;
    pg8::MixedOrder S; S.init(N, K / 256, (int)gridDim.x, (int)blockIdx.x);
    pg8::gemm_phase<Epi, pg8::MixedOrder>(lds, g, S, E);
    __syncthreads();
}

DI void rope4(f32x4& v, const float* cs  ) {
    const f32x4 t = *(const f32x4*)cs;
    const float a0 = v[0] * t[0] - v[1] * t[1], a1 = v[0] * t[1] + v[1] * t[0];
    const float b0 = v[2] * t[2] - v[3] * t[3], b1 = v[2] * t[3] + v[3] * t[2];
    v = (f32x4){a0, a1, b0, b1};
}
DI u32x2 pack4(const f32x4& v) { u32x2 r; r.x = pk2(v[0], v[1]); r.y = pk2(v[2], v[3]); return r; }

struct EpiInEven {
    u16* U; u16* CQKV; u16* KC; float* ssq; float* sskv; const float* rope;
    DI void operator()(const AccT& acc, const Unit& u, int wr, int wc, int fr, int fq) const {
#pragma unroll
        for (int ai = 0; ai < 2; ++ai)
#pragma unroll
            for (int m = 0; m < 4; ++m) {
                const int row = EPI_ROW(u, ai, m);
#pragma unroll
                for (int bj = 0; bj < 2; ++bj) {
                    const int cb = EPI_COLBASE(u, bj);
                    if (cb < 512) {
#pragma unroll
                        for (int n = 0; n < 2; ++n) *(u32x2*)(U + (size_t)row * 512 + cb + n * 16 + 4 * fq) = pack4(acc[ai][bj][m][n]);
                    } else if (cb < 896) {
                        float ss = 0.f;
#pragma unroll
                        for (int n = 0; n < 2; ++n) { const f32x4 v = acc[ai][bj][m][n];
                            *(u32x2*)(CQKV + (size_t)row * 384 + (cb - 512) + n * 16 + 4 * fq) = pack4(v);
                            ss += v[0] * v[0] + v[1] * v[1] + v[2] * v[2] + v[3] * v[3]; }
                        ss += __shfl_xor(ss, 16); ss += __shfl_xor(ss, 32);
                        if (fq == 0) { if (cb < 768) ssq[(size_t)row * 8 + ((cb - 512) >> 5)] = ss; else sskv[(size_t)row * 4 + ((cb - 768) >> 5)] = ss; }
                    } else if (cb == 896) {
                        const int b = tok_b(row);
                        const int pos = row < NLAT ? 256 + (row & 8191) : ((row - NLAT) & 255);
#pragma unroll
                        for (int n = 0; n < 2; ++n) { f32x4 v = acc[ai][bj][m][n]; const int d0 = n * 16 + 4 * fq;
                            if (row < NLAT) rope4(v, rope + ((size_t)(row & 8191) * 16 + (d0 >> 1)) * 2);
                            const u32x2 w = pack4(v);
#pragma unroll
                            for (int h = 0; h < 8; ++h) *(u32x2*)(KC + ((size_t)(b * 8 + h) * LK + pos) * 96 + 64 + d0) = w; }
                    }
                }
            }
    }
};

struct EpiQ {
    u16* Q; const float* ssq; const float* rope;
    DI void operator()(const AccT& acc, const Unit& u, int wr, int wc, int fr, int fq) const {
        const float qs = 0.10206207261596577f * 1.4426950408889634f;
#pragma unroll
        for (int ai = 0; ai < 2; ++ai)
#pragma unroll
            for (int m = 0; m < 4; ++m) {
                const int row = EPI_ROW(u, ai, m);
                const f32x4 sa = *(const f32x4*)(ssq + (size_t)row * 8), sb = *(const f32x4*)(ssq + (size_t)row * 8 + 4);
                const float rstd = rsqrtf((((sa[0] + sa[1]) + (sa[2] + sa[3])) + ((sb[0] + sb[1]) + (sb[2] + sb[3]))) * (1.f / 256.f) + EPS) * qs;
                const int b = tok_b(row);
#pragma unroll
                for (int bj = 0; bj < 2; ++bj)
#pragma unroll
                    for (int n = 0; n < 2; ++n) {
                        const int col = EPI_COLBASE(u, bj) + n * 16 + 4 * fq, h = col / 96, dd = col - h * 96;
                        f32x4 v = acc[ai][bj][m][n];
                        if (dd >= 64 && row < NLAT) rope4(v, rope + ((size_t)(row & 8191) * 16 + ((dd - 64) >> 1)) * 2);
                        v = v * rstd;
                        u16* dst = row < NLAT ? Q + ((size_t)(b * 8 + h) * SEQ + (row & 8191)) * 96 + dd
                                              : Q + (size_t)NLAT * 768 + ((size_t)(b * 8 + h) * CTXL + ((row - NLAT) & 255)) * 96 + dd;
                        *(u32x2*)dst = pack4(v);
                    }
            }
    }
};

struct EpiKV {
    u16* KC; u16* VT; const float* sskv;
    DI void operator()(const AccT& acc, const Unit& u, int wr, int wc, int fr, int fq) const {
#pragma unroll
        for (int ai = 0; ai < 2; ++ai)
#pragma unroll
            for (int m = 0; m < 4; ++m) {
                const int row = EPI_ROW(u, ai, m);
                const f32x4 sa = *(const f32x4*)(sskv + (size_t)row * 4);
                const float rstd = rsqrtf(((sa[0] + sa[1]) + (sa[2] + sa[3])) * (1.f / 128.f) + EPS);
                const int b = tok_b(row);
                const int pos = row < NLAT ? 256 + (row & 8191) : ((row - NLAT) & 255);
#pragma unroll
                for (int bj = 0; bj < 2; ++bj)
#pragma unroll
                    for (int n = 0; n < 2; ++n) {
                        const int col = EPI_COLBASE(u, bj) + n * 16 + 4 * fq, h = col >> 7, c2 = col & 127;
                        const f32x4 v = acc[ai][bj][m][n] * rstd;
                        if (c2 < 64) *(u32x2*)(KC + ((size_t)(b * 8 + h) * LK + pos) * 96 + c2) = pack4(v);
                        else {
#pragma unroll
                            for (int j = 0; j < 4; ++j) VT[((size_t)(b * 8 + h) * 64 + (c2 - 64 + j)) * LK + pos] = f2bf(v[j]);
                        }
                    }
            }
    }
};

struct EpiGlu {
    const u16* Z; u16* HB;
    DI void operator()(const AccT& acc, const Unit& u, int wr, int wc, int fr, int fq) const {
#pragma unroll
        for (int ai = 0; ai < 2; ++ai)
#pragma unroll
            for (int m = 0; m < 4; ++m) {
                const int row = EPI_ROW(u, ai, m);
#pragma unroll
                for (int bj = 0; bj < 2; ++bj)
#pragma unroll
                    for (int n = 0; n < 2; ++n) {
                        const int col = EPI_COLBASE(u, bj) + n * 16 + 4 * fq;
                        const u32x2 z = *(const u32x2*)(Z + (size_t)row * 512 + col);
                        const f32x4 a = acc[ai][bj][m][n];
                        f32x4 o; o[0] = bflo(z.x) * sigmoidf_(a[0]); o[1] = bfhi(z.x) * sigmoidf_(a[1]); o[2] = bflo(z.y) * sigmoidf_(a[2]); o[3] = bfhi(z.y) * sigmoidf_(a[3]);
                        *(u32x2*)(HB + (size_t)row * 1024 + col) = pack4(o);
                    }
            }
    }
};

struct EpiRes {
    const float* srcLat; const float* srcCtx; const float* gate  ; float* X; float* part;
    DI void operator()(const AccT& acc, const Unit& u, int wr, int wc, int fr, int fq) const {
#pragma unroll
        for (int ai = 0; ai < 2; ++ai)
#pragma unroll
            for (int m = 0; m < 4; ++m) {
                const int row = EPI_ROW(u, ai, m);
                if (u.ks >= 0) {
                    float* pr = part + ((size_t)u.ks * NCTX + (row - NLAT)) * 1024;
#pragma unroll
                    for (int bj = 0; bj < 2; ++bj)
#pragma unroll
                        for (int n = 0; n < 2; ++n) *(f32x4*)(pr + EPI_COLBASE(u, bj) + n * 16 + 4 * fq) = acc[ai][bj][m][n];
                } else {
                    const float* src = row < NLAT ? srcLat + (size_t)row * 1024 : srcCtx + (size_t)(row - NLAT) * 1024;
                    const float* gv = gate + tok_bidx(row) * 6144;
#pragma unroll
                    for (int bj = 0; bj < 2; ++bj)
#pragma unroll
                        for (int n = 0; n < 2; ++n) {
                            const int col = EPI_COLBASE(u, bj) + n * 16 + 4 * fq;
                            const f32x4 s = *(const f32x4*)(src + col), gg = *(const f32x4*)(gv + col);
                            *(f32x4*)(X + (size_t)row * 1024 + col) = s + gg * acc[ai][bj][m][n];
                        }
                }
            }
    }
};

struct EpiFFN1 {
    u16* ACT;
    DI void operator()(const AccT& acc, const Unit& u, int wr, int wc, int fr, int fq) const {
#pragma unroll
        for (int ai = 0; ai < 2; ++ai)
#pragma unroll
            for (int m = 0; m < 4; ++m) {
                const int row = EPI_ROW(u, ai, m);
#pragma unroll
                for (int bj = 0; bj < 2; ++bj) {
                    const int col = (EPI_COLBASE(u, bj) >> 1) + 4 * fq;
                    const f32x4 g = acc[ai][bj][m][0], up = acc[ai][bj][m][1];
                    f32x4 o; o[0] = siluf_(g[0]) * up[0]; o[1] = siluf_(g[1]) * up[1]; o[2] = siluf_(g[2]) * up[2]; o[3] = siluf_(g[3]) * up[3];
                    *(u32x2*)(ACT + (size_t)row * DFF + col) = pack4(o);
                }
            }
    }
};

struct EpiInOdd {
    u16* PROJ; const float* rope;
    DI void operator()(const AccT& acc, const Unit& u, int wr, int wc, int fr, int fq) const {
#pragma unroll
        for (int ai = 0; ai < 2; ++ai)
#pragma unroll
            for (int m = 0; m < 4; ++m) {
                const int row = EPI_ROW(u, ai, m);
#pragma unroll
                for (int bj = 0; bj < 2; ++bj) {
                    const int cb = EPI_COLBASE(u, bj), seg = cb >> 9;
#pragma unroll
                    for (int n = 0; n < 2; ++n) {
                        const int col = cb + n * 16 + 4 * fq;
                        f32x4 v = acc[ai][bj][m][n];
                        if (seg < 2) {
                            if (row < NLAT) rope4(v, rope + ((size_t)(row & 8191) * 64 + ((col & 127) >> 1)) * 2);
                            if (seg == 1) v = v * 0.08838834764831845f;
                        }
                        *(u32x2*)(PROJ + (size_t)row * 4608 + col) = pack4(v);
                    }
                }
            }
    }
};

struct ConvJob { const float* src; u16* dst; const float* rowscale; int K, N, lds_, Npad, ldd, koff, inter; };
DI void conv_job(const ConvJob& J, float* tile) {
    const int tid = tidx(), ntn = J.Npad / 64, tiles = (J.K / 64) * ntn;
    for (int t = blockIdx.x; t < tiles; t += gridDim.x) {
        const int kt = t / ntn, nt = t - kt * ntn;
#pragma unroll
        for (int i = 0; i < 8; ++i) {
            const int kl = (tid >> 6) + 8 * i, nl = tid & 63, k = kt * 64 + kl, n = nt * 64 + nl;
            float v = 0.f;
            if (n < J.N) { v = J.src[(size_t)k * J.lds_ + n]; if (J.rowscale) v *= J.rowscale[k]; }
            tile[kl * 65 + nl] = v;
        }
        __syncthreads();
#pragma unroll
        for (int i = 0; i < 8; ++i) {
            const int nl = (tid >> 6) + 8 * i, kl = tid & 63, n = nt * 64 + nl;
            const int drow = J.inter ? (32 * (n >> 4) + (n & 15) + (J.inter == 2 ? 16 : 0)) : n;
            J.dst[(size_t)drow * J.ldd + J.koff + kt * 64 + kl] = f2bf(tile[kl * 65 + nl]);
        }
        __syncthreads();
    }
}
DI void conv_mixer_weights(const Params& p, int li, float* tile) {
    unsigned char* W = p.ws + OFF_WMIX;
    const int j = li >> 1;
    if ((li & 1) == 0) {
        ConvJob a{p.in[11] + (size_t)j * 1024 * 928, (u16*)(W + WE_IN), nullptr, 1024, 928, 928, 1024, 1024, 0, 0}; conv_job(a, tile);
        ConvJob b{p.in[12] + (size_t)j * 1024 * 1024, (u16*)(W + WE_OUT), nullptr, 1024, 1024, 1024, 1024, 1024, 0, 0}; conv_job(b, tile);
        ConvJob c{p.in[21] + (size_t)j * 512 * 512, (u16*)(W + WE_GLU), nullptr, 512, 512, 512, 512, 512, 0, 0}; conv_job(c, tile);
        ConvJob d{p.in[23] + (size_t)j * 256 * 768, (u16*)(W + WE_UQ), p.in[22] + j * 256, 256, 768, 768, 768, 256, 0, 0}; conv_job(d, tile);
        ConvJob e{p.in[25] + (size_t)j * 128 * 1024, (u16*)(W + WE_UKV), p.in[24] + j * 128, 128, 1024, 1024, 1024, 256, 128, 0}; conv_job(e, tile);
        u16* z = (u16*)(W + WE_UKV);
        for (int i = blockIdx.x * 512 + tidx(); i < 1024 * 128; i += gridDim.x * 512) z[(size_t)(i >> 7) * 256 + (i & 127)] = 0;
    } else {
        ConvJob a{p.in[26] + (size_t)j * 1024 * 4608, (u16*)(W + WO_IN), nullptr, 1024, 4608, 4608, 4608, 1024, 0, 0}; conv_job(a, tile);
        ConvJob b{p.in[27] + (size_t)j * 1024 * 1024, (u16*)(W + WO_OUT), nullptr, 1024, 1024, 1024, 1024, 1024, 0, 0}; conv_job(b, tile);
    }
}
DI void conv_ffn_weights(const Params& p, int li, float* tile) {
    unsigned char* W = p.ws + OFF_WFFN;
    ConvJob a{p.in[8] + (size_t)li * 1024 * DFF, (u16*)(W + WF_13), nullptr, 1024, DFF, DFF, DFF, 1024, 0, 1}; conv_job(a, tile);
    ConvJob b{p.in[9] + (size_t)li * 1024 * DFF, (u16*)(W + WF_13), nullptr, 1024, DFF, DFF, DFF, 1024, 0, 2}; conv_job(b, tile);
    ConvJob c{p.in[10] + (size_t)li * DFF * 1024, (u16*)(W + WF_2), nullptr, DFF, 1024, 1024, 1024, DFF, 0, 0}; conv_job(c, tile);
}

DI void norm_rows(const float* srcLat, const float* srcCtx, const float* g, const float* modl, int aoff, int soff, u16* H,
                  const float* part, int KS, const float* gctx, float* xw) {
    const int wid = tidx() >> 6, lane = tidx() & 63;
    for (int row = blockIdx.x * 8 + wid; row < NTOK; row += gridDim.x * 8) {
        const float* src = row < NLAT ? srcLat + (size_t)row * 1024 : srcCtx + (size_t)(row - NLAT) * 1024;
        const float* mv = modl + tok_bidx(row) * 6144;
        f32x4 v[4]; float ss = 0.f;
#pragma unroll
        for (int i = 0; i < 4; ++i) v[i] = *(const f32x4*)(src + i * 256 + lane * 4);
        if (part != nullptr && row >= NLAT) {
#pragma unroll
            for (int i = 0; i < 4; ++i) { const int col = i * 256 + lane * 4; f32x4 a = (f32x4){0.f, 0.f, 0.f, 0.f};
                for (int k = 0; k < KS; ++k) a += *(const f32x4*)(part + ((size_t)k * NCTX + (row - NLAT)) * 1024 + col);
                v[i] += *(const f32x4*)(gctx + col) * a;
                *(f32x4*)(xw + (size_t)row * 1024 + col) = v[i]; }
        }
#pragma unroll
        for (int i = 0; i < 4; ++i) ss += v[i][0] * v[i][0] + v[i][1] * v[i][1] + v[i][2] * v[i][2] + v[i][3] * v[i][3];
#pragma unroll
        for (int o = 1; o < 64; o <<= 1) ss += __shfl_xor(ss, o);
        const float rstd = rsqrtf(ss * (1.f / 1024.f) + EPS);
#pragma unroll
        for (int i = 0; i < 4; ++i) {
            const int col = i * 256 + lane * 4;
            const f32x4 gg = *(const f32x4*)(g + col), a = *(const f32x4*)(mv + aoff + col), s = *(const f32x4*)(mv + soff + col);
            const f32x4 h = v[i] * rstd * gg * (a + 1.f) + s;
            *(u32x2*)(H + (size_t)row * 1024 + col) = pack4(h);
        }
    }
}
DI void final_norm_rows(const float* X, const float* g, float* out) {
    const int wid = tidx() >> 6, lane = tidx() & 63;
    for (int row = blockIdx.x * 8 + wid; row < NLAT; row += gridDim.x * 8) {
        const float* src = X + (size_t)row * 1024;
        f32x4 v[4]; float ss = 0.f;
#pragma unroll
        for (int i = 0; i < 4; ++i) { v[i] = *(const f32x4*)(src + i * 256 + lane * 4); ss += v[i][0] * v[i][0] + v[i][1] * v[i][1] + v[i][2] * v[i][2] + v[i][3] * v[i][3]; }
#pragma unroll
        for (int o = 1; o < 64; o <<= 1) ss += __shfl_xor(ss, o);
        const float rstd = rsqrtf(ss * (1.f / 1024.f) + EPS);
#pragma unroll
        for (int i = 0; i < 4; ++i) { const int col = i * 256 + lane * 4; *(f32x4*)(out + (size_t)row * 1024 + col) = v[i] * rstd * *(const f32x4*)(g + col); }
    }
}

DI void prep_phase(const Params& p, float* ldsf) {
    const int tid = tidx(), gt = blockIdx.x * 512 + tid, gs = gridDim.x * 512;
    float* mod = (float*)(p.ws + OFF_MOD);
    {
        for (int i = tid; i < 3072; i += 512) { const int v = i >> 10, k = i & 1023; const float x = v < 2 ? p.in[1][v * 1024 + k] : p.in[3][k]; ldsf[i] = siluf_(x); }
        __syncthreads();
        for (int u = blockIdx.x; u < 4 * 12 * 16; u += gridDim.x) {
            const int ks = u & 15, cbk = (u >> 4) % 12, li = u / 192, n = cbk * 512 + tid, k0 = ks * 64;
            const float* w = p.in[4] + ((size_t)li * 1024 + k0) * 6144 + n;
            float a0 = 0.f, a1 = 0.f, a2 = 0.f;
#pragma unroll 16
            for (int k = 0; k < 64; ++k) { const float wv = w[(size_t)k * 6144]; a0 += ldsf[k0 + k] * wv; a1 += ldsf[1024 + k0 + k] * wv; a2 += ldsf[2048 + k0 + k] * wv; }
            if (ks == 0) { const float bm = p.in[5][li * 6144 + n]; a0 += bm; a1 += bm; a2 += bm; }
            float* mp = (float*)(p.ws + OFF_MODP) + (size_t)ks * (4 * 3 * 6144);
            mp[(li * 3 + 0) * 6144 + n] = a0; mp[(li * 3 + 1) * 6144 + n] = a1; mp[(li * 3 + 2) * 6144 + n] = a2;
        }
        __syncthreads();
    }
    float* rm = (float*)(p.ws + OFF_RMLA); float* rr = (float*)(p.ws + OFF_RRET);
    for (int i = gt; i < 8192 * 16; i += gs) { const int l = i >> 4, q = i & 15, r = l >> 6, c = l & 63;
        const float inv = powf(10000.f, -(float)(q & 7) / 8.f); const float ang = (float)(q < 8 ? r : c) * inv;
        float sn, cs; sincosf(ang, &sn, &cs); rm[2 * i] = cs; rm[2 * i + 1] = sn; }
    for (int i = gt; i < 8192 * 64; i += gs) { const int l = i >> 6, q = i & 63, r = l >> 6, c = l & 63;
        const float inv = powf(10000.f, -(float)(q & 31) / 32.f); const float ang = (float)(q < 32 ? r : c) * inv;
        float sn, cs; sincosf(ang, &sn, &cs); rr[2 * i] = cs; rr[2 * i + 1] = sn; }
    float* lb = (float*)(p.ws + OFF_LB);
    for (int i = gt; i < 512; i += gs) { const float a = p.in[29][i], b = p.in[29][512 + i], c = p.in[29][1024 + i]; const float mx = fmaxf(a, fmaxf(b, c));
        const float ea = expf(a - mx), eb = expf(b - mx), ec = expf(c - mx), s = ea + eb + ec; lb[i] = ea / s; lb[512 + i] = (ea + eb) / s; }
    float2* sab = (float2*)(p.ws + OFF_SAB); float2* sa64 = (float2*)(p.ws + OFF_SA64); float2* sbb = (float2*)(p.ws + OFF_SBB); u16* scc = (u16*)(p.ws + OFF_SCC);
    for (int i = gt; i < 2 * 2 * 2048; i += gs) {
        const int gp = i & 2047, jr = i >> 11, g = gp >> 6, pp = gp & 63;
        const double are = p.in[13][i], aim = p.in[14][i], dt = exp((double)p.in[15][jr * 32 + g]);
        const double mag = exp(are * dt), abr = mag * cos(aim * dt), abi = mag * sin(aim * dt);
        sab[i] = make_float2((float)abr, (float)abi);
        const double m64 = exp(are * dt * 64.0); sa64[i] = make_float2((float)(m64 * cos(aim * dt * 64.0)), (float)(m64 * sin(aim * dt * 64.0)));
        const double nr = abr - 1.0, ni = abi, den = are * are + aim * aim;
        const double fr = (nr * are + ni * aim) / den, fi = (ni * are - nr * aim) / den;
        { u16* sbbt = (u16*)sbb;
          for (int k = 0; k < 16; ++k) { const double br = p.in[16][(size_t)i * 16 + k], bi = p.in[17][(size_t)i * 16 + k];
            sbbt[((size_t)(jr * 32 + g) * 128 + pp) * 16 + k] = f2bf((float)(fr * br - fi * bi));
            sbbt[((size_t)(jr * 32 + g) * 128 + 64 + pp) * 16 + k] = f2bf((float)(fr * bi + fi * br)); } }
        for (int k = 0; k < 16; ++k) { const size_t ci = ((size_t)(jr * 32 + g) * 16 + k) * 64 + pp;
            scc[((size_t)(jr * 32 + g) * 16 + k) * 128 + pp] = f2bf(p.in[18][ci]); scc[((size_t)(jr * 32 + g) * 16 + k) * 128 + 64 + pp] = f2bf(-p.in[19][ci]); }
    }
    conv_mixer_weights(p, 0, ldsf);
}

constexpr int AT_KROW = 208, AT_VROW = 144, AT_KBUF = 64 * AT_KROW, AT_VBUF = 64 * AT_VROW, AT_BUF = AT_KBUF + AT_VBUF;
DI void attn_unit(LAS unsigned char* lds, const u16* Qp, const u16* Kp, const u16* Vp, int nkt, u16* outp) {
    const int tid = tidx(), wid = tid >> 6, lane = tid & 63, l31 = lane & 31, hh = lane >> 5;
    bf16x8 qf[6];
    { const u16* qr = Qp + (size_t)(wid * 32 + l31) * 96 + 8 * hh;
#pragma unroll
      for (int s = 0; s < 6; ++s) qf[s] = *(const bf16x8*)(qr + 16 * s); }
    f32x16 o0, o1;
#pragma unroll
    for (int i = 0; i < 16; ++i) { o0[i] = 0.f; o1[i] = 0.f; }
    float m_run = -1e30f, lsum = 0.f;
    const int kr0 = tid / 12, kp0 = tid - kr0 * 12, c1 = 512 + tid, kr1 = c1 / 12, kp1 = c1 - kr1 * 12, vr = tid >> 3, vp = tid & 7;
    u32x4 rk0, rk1 = (u32x4){0u, 0u, 0u, 0u}, rv;
    rk0 = *(const u32x4*)(Kp + (size_t)kr0 * 96 + kp0 * 8);
    if (tid < 256) rk1 = *(const u32x4*)(Kp + (size_t)kr1 * 96 + kp1 * 8);
    rv = *(const u32x4*)(Vp + (size_t)vr * LK + vp * 8);
    *(LAS u32x4*)(lds + kr0 * AT_KROW + kp0 * 16) = rk0;
    if (tid < 256) *(LAS u32x4*)(lds + kr1 * AT_KROW + kp1 * 16) = rk1;
    *(LAS u32x4*)(lds + AT_KBUF + vr * AT_VROW + vp * 16) = rv;
    __syncthreads();
    for (int kt = 0; kt < nkt; ++kt) {
        LAS unsigned char* kb_ = lds + (kt & 1) * AT_BUF; LAS unsigned char* vb_ = kb_ + AT_KBUF;
        const bool more = kt + 1 < nkt;
        if (more) { const u16* kn = Kp + (size_t)(kt + 1) * 64 * 96; const u16* vn = Vp + (size_t)(kt + 1) * 64;
            rk0 = *(const u32x4*)(kn + (size_t)kr0 * 96 + kp0 * 8);
            if (tid < 256) rk1 = *(const u32x4*)(kn + (size_t)kr1 * 96 + kp1 * 8);
            rv = *(const u32x4*)(vn + (size_t)vr * LK + vp * 8); }
        f32x16 st0, st1;
#pragma unroll
        for (int i = 0; i < 16; ++i) { st0[i] = 0.f; st1[i] = 0.f; }
#pragma unroll
        for (int s = 0; s < 6; ++s) {
            const bf16x8 a0 = *(const LAS bf16x8*)(kb_ + l31 * AT_KROW + (16 * s + 8 * hh) * 2);
            const bf16x8 a1 = *(const LAS bf16x8*)(kb_ + (32 + l31) * AT_KROW + (16 * s + 8 * hh) * 2);
            st0 = MFMA32(a0, qf[s], st0); st1 = MFMA32(a1, qf[s], st1);
        }
        float mx = st0[0];
#pragma unroll
        for (int i = 0; i < 16; ++i) { mx = fmaxf(mx, st0[i]); mx = fmaxf(mx, st1[i]); }
        mx = fmaxf(mx, __shfl_xor(mx, 32));
        const float m_new = fmaxf(m_run, mx), alpha = __builtin_amdgcn_exp2f(m_run - m_new);
        m_run = m_new;
        float ps = 0.f;
#pragma unroll
        for (int i = 0; i < 16; ++i) { st0[i] = __builtin_amdgcn_exp2f(st0[i] - m_new); st1[i] = __builtin_amdgcn_exp2f(st1[i] - m_new); ps += st0[i] + st1[i]; }
        lsum = lsum * alpha + ps;
#pragma unroll
        for (int i = 0; i < 16; ++i) { o0[i] *= alpha; o1[i] *= alpha; }
#pragma unroll
        for (int kb = 0; kb < 2; ++kb)
#pragma unroll
            for (int s = 0; s < 2; ++s) {
                u32x4 pw;
                if (kb == 0) { pw.x = pk2(st0[8 * s], st0[8 * s + 1]); pw.y = pk2(st0[8 * s + 2], st0[8 * s + 3]); pw.z = pk2(st0[8 * s + 4], st0[8 * s + 5]); pw.w = pk2(st0[8 * s + 6], st0[8 * s + 7]); }
                else         { pw.x = pk2(st1[8 * s], st1[8 * s + 1]); pw.y = pk2(st1[8 * s + 2], st1[8 * s + 3]); pw.z = pk2(st1[8 * s + 4], st1[8 * s + 5]); pw.w = pk2(st1[8 * s + 6], st1[8 * s + 7]); }
                const bf16x8 pb = __builtin_bit_cast(bf16x8, pw);
                const int koff = (32 * kb + 16 * s + 4 * hh) * 2;
                { const u32x2 lo = *(const LAS u32x2*)(vb_ + l31 * AT_VROW + koff), hi = *(const LAS u32x2*)(vb_ + l31 * AT_VROW + koff + 16);
                  u32x4 va; va.x = lo.x; va.y = lo.y; va.z = hi.x; va.w = hi.y; o0 = MFMA32(__builtin_bit_cast(bf16x8, va), pb, o0); }
                { const u32x2 lo = *(const LAS u32x2*)(vb_ + (32 + l31) * AT_VROW + koff), hi = *(const LAS u32x2*)(vb_ + (32 + l31) * AT_VROW + koff + 16);
                  u32x4 va; va.x = lo.x; va.y = lo.y; va.z = hi.x; va.w = hi.y; o1 = MFMA32(__builtin_bit_cast(bf16x8, va), pb, o1); }
            }
        if (more) { LAS unsigned char* nb = lds + ((kt + 1) & 1) * AT_BUF;
            *(LAS u32x4*)(nb + kr0 * AT_KROW + kp0 * 16) = rk0;
            if (tid < 256) *(LAS u32x4*)(nb + kr1 * AT_KROW + kp1 * 16) = rk1;
            *(LAS u32x4*)(nb + AT_KBUF + vr * AT_VROW + vp * 16) = rv; }
        __syncthreads();
    }
    const float lt = lsum + __shfl_xor(lsum, 32), inv = 1.f / lt;
    u16* orow = outp + (size_t)(wid * 32 + l31) * 1024;
#pragma unroll
    for (int g = 0; g < 4; ++g) {
        u32x2 w0, w1;
        w0.x = pk2(o0[4 * g] * inv, o0[4 * g + 1] * inv); w0.y = pk2(o0[4 * g + 2] * inv, o0[4 * g + 3] * inv);
        w1.x = pk2(o1[4 * g] * inv, o1[4 * g + 1] * inv); w1.y = pk2(o1[4 * g + 2] * inv, o1[4 * g + 3] * inv);
        *(u32x2*)(orow + 8 * g + 4 * hh) = w0; *(u32x2*)(orow + 32 + 8 * g + 4 * hh) = w1;
    }
}


DI void attn_unit64(LAS unsigned char* lds, const u16* Qp, const u16* Kp, const u16* Vp, int nkt, u16* outp) {
    const int tid = tidx(), wid = tid >> 6, lane = tid & 63, l31 = lane & 31, hh = lane >> 5;
    bf16x8 qf0[6], qf1[6];
    { const u16* qr = Qp + (size_t)(wid * 64 + l31) * 96 + 8 * hh;
#pragma unroll
      for (int s = 0; s < 6; ++s) { qf0[s] = *(const bf16x8*)(qr + 16 * s); qf1[s] = *(const bf16x8*)(qr + 32 * 96 + 16 * s); } }
    f32x16 oa0, oa1, ob0, ob1;
#pragma unroll
    for (int i = 0; i < 16; ++i) { oa0[i] = 0.f; oa1[i] = 0.f; ob0[i] = 0.f; ob1[i] = 0.f; }
    float ma = -1e30f, mb = -1e30f, la = 0.f, lb = 0.f;
    const int kr0 = tid / 12, kp0 = tid - kr0 * 12, c1 = 512 + tid, kr1 = c1 / 12, kp1 = c1 - kr1 * 12, vr = tid >> 3, vp = tid & 7;
    u32x4 rk0, rk1 = (u32x4){0u, 0u, 0u, 0u}, rv;
    rk0 = *(const u32x4*)(Kp + (size_t)kr0 * 96 + kp0 * 8);
    if (tid < 256) rk1 = *(const u32x4*)(Kp + (size_t)kr1 * 96 + kp1 * 8);
    rv = *(const u32x4*)(Vp + (size_t)vr * LK + vp * 8);
    *(LAS u32x4*)(lds + kr0 * AT_KROW + kp0 * 16) = rk0;
    if (tid < 256) *(LAS u32x4*)(lds + kr1 * AT_KROW + kp1 * 16) = rk1;
    *(LAS u32x4*)(lds + AT_KBUF + vr * AT_VROW + vp * 16) = rv;
    __syncthreads();
    for (int kt = 0; kt < nkt; ++kt) {
        LAS unsigned char* kb_ = lds + (kt & 1) * AT_BUF; LAS unsigned char* vb_ = kb_ + AT_KBUF;
        const bool more = kt + 1 < nkt;
        if (more) { const u16* kn = Kp + (size_t)(kt + 1) * 64 * 96; const u16* vn = Vp + (size_t)(kt + 1) * 64;
            rk0 = *(const u32x4*)(kn + (size_t)kr0 * 96 + kp0 * 8);
            if (tid < 256) rk1 = *(const u32x4*)(kn + (size_t)kr1 * 96 + kp1 * 8);
            rv = *(const u32x4*)(vn + (size_t)vr * LK + vp * 8); }
        f32x16 sa0, sa1, sb0, sb1;
#pragma unroll
        for (int i = 0; i < 16; ++i) { sa0[i] = 0.f; sa1[i] = 0.f; sb0[i] = 0.f; sb1[i] = 0.f; }
#pragma unroll
        for (int s = 0; s < 6; ++s) {
            const bf16x8 a0 = *(const LAS bf16x8*)(kb_ + l31 * AT_KROW + (16 * s + 8 * hh) * 2);
            const bf16x8 a1 = *(const LAS bf16x8*)(kb_ + (32 + l31) * AT_KROW + (16 * s + 8 * hh) * 2);
            sa0 = MFMA32(a0, qf0[s], sa0); sa1 = MFMA32(a1, qf0[s], sa1);
            sb0 = MFMA32(a0, qf1[s], sb0); sb1 = MFMA32(a1, qf1[s], sb1);
        }
        u32x4 pa[4], pb[4];
#define AT_SOFTMAX(S0, S1, M, L, O0, O1, P) do { \
        float mx = S0[0]; \
        _Pragma("unroll") for (int i = 0; i < 16; ++i) { mx = fmaxf(mx, S0[i]); mx = fmaxf(mx, S1[i]); } \
        { const auto sw_ = __builtin_amdgcn_permlane32_swap(__float_as_uint(mx), __float_as_uint(mx), false, false); \
          mx = fmaxf(__uint_as_float(sw_[0]), __uint_as_float(sw_[1])); }     \
        const float m_new = fmaxf(M, mx); \
        if (__builtin_amdgcn_ballot_w64(mx > M + 8.0f) != 0ull) {     const float alpha = __builtin_amdgcn_exp2f(M - m_new); M = m_new; L *= alpha; \
            _Pragma("unroll") for (int i = 0; i < 16; ++i) { O0[i] *= alpha; O1[i] *= alpha; } } \
        float ps = 0.f; \
        _Pragma("unroll") for (int i = 0; i < 16; ++i) { S0[i] = __builtin_amdgcn_exp2f(S0[i] - M); S1[i] = __builtin_amdgcn_exp2f(S1[i] - M); ps += S0[i] + S1[i]; } \
        L += ps; \
        _Pragma("unroll") for (int s = 0; s < 2; ++s) { \
            P[s].x = pk2(S0[8 * s], S0[8 * s + 1]); P[s].y = pk2(S0[8 * s + 2], S0[8 * s + 3]); P[s].z = pk2(S0[8 * s + 4], S0[8 * s + 5]); P[s].w = pk2(S0[8 * s + 6], S0[8 * s + 7]); \
            P[2 + s].x = pk2(S1[8 * s], S1[8 * s + 1]); P[2 + s].y = pk2(S1[8 * s + 2], S1[8 * s + 3]); P[2 + s].z = pk2(S1[8 * s + 4], S1[8 * s + 5]); P[2 + s].w = pk2(S1[8 * s + 6], S1[8 * s + 7]); } \
        } while (0)
        AT_SOFTMAX(sa0, sa1, ma, la, oa0, oa1, pa);
        AT_SOFTMAX(sb0, sb1, mb, lb, ob0, ob1, pb);
#undef AT_SOFTMAX
#pragma unroll
        for (int kb = 0; kb < 2; ++kb)
#pragma unroll
            for (int s = 0; s < 2; ++s) {
                const int koff = (32 * kb + 16 * s + 4 * hh) * 2;
                const u32x2 lo0 = *(const LAS u32x2*)(vb_ + l31 * AT_VROW + koff), hi0 = *(const LAS u32x2*)(vb_ + l31 * AT_VROW + koff + 16);
                const u32x2 lo1 = *(const LAS u32x2*)(vb_ + (32 + l31) * AT_VROW + koff), hi1 = *(const LAS u32x2*)(vb_ + (32 + l31) * AT_VROW + koff + 16);
                u32x4 va0, va1; va0.x = lo0.x; va0.y = lo0.y; va0.z = hi0.x; va0.w = hi0.y; va1.x = lo1.x; va1.y = lo1.y; va1.z = hi1.x; va1.w = hi1.y;
                const bf16x8 v0 = __builtin_bit_cast(bf16x8, va0), v1 = __builtin_bit_cast(bf16x8, va1);
                const bf16x8 pA = __builtin_bit_cast(bf16x8, pa[kb * 2 + s]), pB = __builtin_bit_cast(bf16x8, pb[kb * 2 + s]);
                oa0 = MFMA32(v0, pA, oa0); oa1 = MFMA32(v1, pA, oa1);
                ob0 = MFMA32(v0, pB, ob0); ob1 = MFMA32(v1, pB, ob1);
            }
        if (more) { LAS unsigned char* nb = lds + ((kt + 1) & 1) * AT_BUF;
            *(LAS u32x4*)(nb + kr0 * AT_KROW + kp0 * 16) = rk0;
            if (tid < 256) *(LAS u32x4*)(nb + kr1 * AT_KROW + kp1 * 16) = rk1;
            *(LAS u32x4*)(nb + AT_KBUF + vr * AT_VROW + vp * 16) = rv; }
        __syncthreads();
    }
    {   const float lt = la + __shfl_xor(la, 32), inv = 1.f / lt;
        u16* orow = outp + (size_t)(wid * 64 + l31) * 1024;
#pragma unroll
        for (int g = 0; g < 4; ++g) { u32x2 w0, w1;
            w0.x = pk2(oa0[4 * g] * inv, oa0[4 * g + 1] * inv); w0.y = pk2(oa0[4 * g + 2] * inv, oa0[4 * g + 3] * inv);
            w1.x = pk2(oa1[4 * g] * inv, oa1[4 * g + 1] * inv); w1.y = pk2(oa1[4 * g + 2] * inv, oa1[4 * g + 3] * inv);
            *(u32x2*)(orow + 8 * g + 4 * hh) = w0; *(u32x2*)(orow + 32 + 8 * g + 4 * hh) = w1; } }
    {   const float lt = lb + __shfl_xor(lb, 32), inv = 1.f / lt;
        u16* orow = outp + (size_t)(wid * 64 + 32 + l31) * 1024;
#pragma unroll
        for (int g = 0; g < 4; ++g) { u32x2 w0, w1;
            w0.x = pk2(ob0[4 * g] * inv, ob0[4 * g + 1] * inv); w0.y = pk2(ob0[4 * g + 2] * inv, ob0[4 * g + 3] * inv);
            w1.x = pk2(ob1[4 * g] * inv, ob1[4 * g + 1] * inv); w1.y = pk2(ob1[4 * g + 2] * inv, ob1[4 * g + 3] * inv);
            *(u32x2*)(orow + 8 * g + 4 * hh) = w0; *(u32x2*)(orow + 32 + 8 * g + 4 * hh) = w1; } }
}

DI int s5_rowbase(int b, int jc) { return jc < 4 ? NLAT + b * 256 + jc * 64 : b * 8192 + (jc - 4) * 64; }
constexpr int S5_BU = 16 * 132 * 4, S5_HB = 16 * 136 * 2, S5_WAVE = S5_BU + S5_HB;
#define S5_WAVE_SYNC() do { asm volatile("s_waitcnt vmcnt(0) lgkmcnt(0)" ::: "memory"); __builtin_amdgcn_wave_barrier(); } while (0)
template <bool WITH_C>
DI void s5_dir(const Params& p, int j, int dir, int g, int rowbase, float& hr, float& hi, f32x4 (&acc)[4], unsigned char* lw) {
    const int lane = tidx() & 63, lq = lane >> 4, l15 = lane & 15, gp = g * 64 + lane;
    const int tdir = (j * 2 + dir);
    const float2 A = ((const float2*)(p.ws + OFF_SAB))[tdir * 2048 + gp];
    const u16* U = (const u16*)(p.ws + OFF_BIG + BE_U);
    const u16* sbbt = (const u16*)(p.ws + OFF_SBB) + (size_t)(tdir * 32 + g) * 128 * 16;
    const bf16x8 zero8 = (bf16x8){0, 0, 0, 0, 0, 0, 0, 0};
    bf16x8 bfr[8];
#pragma unroll
    for (int nt = 0; nt < 8; ++nt) bfr[nt] = lq < 2 ? *(const bf16x8*)(sbbt + (16 * nt + l15) * 16 + 8 * lq) : zero8;
    bf16x8 cf[4];
    if (WITH_C) { const u16* cp = (const u16*)(p.ws + OFF_SCC) + ((size_t)(tdir * 32 + g) * 16 + l15) * 128 + 8 * lq;
#pragma unroll
        for (int s = 0; s < 4; ++s) cf[s] = *(const bf16x8*)(cp + 32 * s); }
    bf16x8 ua[4];
#pragma unroll
    for (int sb = 0; sb < 4; ++sb) ua[sb] = lq < 2 ? *(const bf16x8*)(U + (size_t)(rowbase + 16 * sb + l15) * 512 + g * 16 + 8 * lq) : zero8;
    float* bu = (float*)lw; u16* hb = (u16*)(lw + S5_BU);
#pragma unroll
    for (int sbi = 0; sbi < 4; ++sbi) {
        const int sb = dir ? 3 - sbi : sbi;
#pragma unroll
        for (int nt = 0; nt < 8; ++nt) {
            const f32x4 c = MFMA16(ua[sb], bfr[nt], ((f32x4){0.f, 0.f, 0.f, 0.f}));
#pragma unroll
            for (int i = 0; i < 4; ++i) bu[(4 * lq + i) * 132 + 16 * nt + l15] = c[i];
        }
        S5_WAVE_SYNC();
        for (int tt = 0; tt < 16; ++tt) {
            const int tl = dir ? 15 - tt : tt;
            const float br = bu[tl * 132 + lane], bi = bu[tl * 132 + 64 + lane];
            const float nr = A.x * hr - A.y * hi + br, ni = A.x * hi + A.y * hr + bi; hr = nr; hi = ni;
            if (WITH_C) { hb[tl * 136 + lane] = f2bf(hr); hb[tl * 136 + 64 + lane] = f2bf(hi); }
        }
        S5_WAVE_SYNC();
        if (WITH_C) {
            f32x4 a = (f32x4){0.f, 0.f, 0.f, 0.f};
#pragma unroll
            for (int s = 0; s < 4; ++s) { const bf16x8 af = *(const bf16x8*)(hb + l15 * 136 + 32 * s + 8 * lq); a = MFMA16(af, cf[s], a); }
            acc[sb] += a;
        }
    }
}
DI void s5_pass1_unit(const Params& p, int j, int unit, unsigned char* l) {
    const int gb = unit & 3, jc = (unit >> 2) % NCH, b = (unit >> 2) / NCH;
    const int tid = tidx(), w = tid >> 6, lane = tid & 63, g = gb * 8 + w, gp = g * 64 + lane;
    float2* E = (float2*)(p.ws + OFF_BIG + BE_S5E);
    const int rowbase = s5_rowbase(b, jc);
    f32x4 acc[4];
    __syncthreads();
#pragma unroll
    for (int dir = 0; dir < 2; ++dir) {
        float hr = 0.f, hi = 0.f;
        s5_dir<false>(p, j, dir, g, rowbase, hr, hi, acc, l + w * S5_WAVE);
        E[((size_t)(b * 2 + dir) * NCH + scan_idx(jc, dir)) * 2048 + gp] = make_float2(hr, hi);
    }
}
DI void s5_carry_scan(const Params& p, int j, int wg0) {
    const int nw = (int)gridDim.x - wg0;
    if ((int)blockIdx.x < wg0) return;
    for (int gt = ((int)blockIdx.x - wg0) * 512 + tidx(); gt < 8192; gt += nw * 512) {
    const int gp = gt & 2047, bd = gt >> 11, dir = bd & 1;
    float2* Ep = (float2*)(p.ws + OFF_BIG + BE_S5E) + (size_t)bd * NCH * 2048 + gp;
    const float2 A64 = ((const float2*)(p.ws + OFF_SA64))[(j * 2 + dir) * 2048 + gp];
    float hr = 0.f, hi = 0.f; asm volatile("" : "+v"(hr), "+v"(hi));
    for (int n0 = 0; n0 < NCH; n0 += 12) {
        float2 e[12];
#pragma unroll
        for (int i = 0; i < 12; ++i) e[i] = Ep[(size_t)(n0 + i) * 2048];
#pragma unroll
        for (int i = 0; i < 12; ++i) { Ep[(size_t)(n0 + i) * 2048] = make_float2(hr, hi);
            const float nr = A64.x * hr - A64.y * hi + e[i].x, ni = A64.x * hi + A64.y * hr + e[i].y; hr = nr; hi = ni; }
    }
    }
}
DI void s5_pass2_unit(const Params& p, int j, int unit, unsigned char* l) {
    const int gb = unit & 3, jc = (unit >> 2) % NCH, b = (unit >> 2) / NCH;
    const int tid = tidx(), w = tid >> 6, lane = tid & 63, g = gb * 8 + w, gp = g * 64 + lane;
    const u16* U = (const u16*)(p.ws + OFF_BIG + BE_U);
    const float2* E = (const float2*)(p.ws + OFF_BIG + BE_S5E);
    u16* Z = (u16*)(p.ws + OFF_BIG + BE_Z);
    const int rowbase = s5_rowbase(b, jc);
    f32x4 acc[4];
#pragma unroll
    for (int i = 0; i < 4; ++i) acc[i] = (f32x4){0.f, 0.f, 0.f, 0.f};
    __syncthreads();
#pragma unroll
    for (int dir = 0; dir < 2; ++dir) {
        const float2 h0 = E[((size_t)(b * 2 + dir) * NCH + scan_idx(jc, dir)) * 2048 + gp];
        float hr = h0.x, hi = h0.y;
        s5_dir<true>(p, j, dir, g, rowbase, hr, hi, acc, l + w * S5_WAVE);
    }
    const int col = g * 16 + (lane & 15);
    const float dcoef = p.in[20][j * 512 + col];
#pragma unroll
    for (int sb = 0; sb < 4; ++sb)
#pragma unroll
        for (int i = 0; i < 4; ++i) {
            const int t = sb * 16 + 4 * (lane >> 4) + i;
            const float y = acc[sb][i] + dcoef * bf2f(U[(size_t)(rowbase + t) * 512 + col]);
            Z[(size_t)(rowbase + t) * 512 + col] = f2bf(gelu_tanh(y));
        }
}

constexpr int GL_S136 = 136, GL_S72 = 72;
constexpr int GL_CUM = 0, GL_QT = 33792, GL_KT = GL_QT + 64 * 136 * 2, GL_QS = GL_KT + 64 * 136 * 2, GL_VT = GL_QS + 64 * 136 * 2, GL_ATT = GL_VT + 128 * 72 * 2, GL_KDT = GL_ATT + 64 * 72 * 2;
DI int gla_rowbase(int b, int jc) { return jc < 4 ? NLAT + b * 256 + jc * 64 : b * 8192 + (jc - 4) * 64; }
DI void ld16(const u16* p, float* f) {
    const u32x4 a = *(const u32x4*)p, b = *(const u32x4*)(p + 8);
    f[0] = bflo(a.x); f[1] = bfhi(a.x); f[2] = bflo(a.y); f[3] = bfhi(a.y); f[4] = bflo(a.z); f[5] = bfhi(a.z); f[6] = bflo(a.w); f[7] = bfhi(a.w);
    f[8] = bflo(b.x); f[9] = bfhi(b.x); f[10] = bflo(b.y); f[11] = bfhi(b.y); f[12] = bflo(b.z); f[13] = bfhi(b.z); f[14] = bflo(b.w); f[15] = bfhi(b.w);
}
DI void gla_cum(unsigned char* l, const u16* PROJ, const float* lbv, int mixer, int h, int dir, int rowbase, float* kv) {
    const int tid = tidx(), t = tid >> 3, d0 = (tid & 7) * 16;
    float* cum = (float*)(l + GL_CUM);
    const u16* prow = PROJ + (size_t)(rowbase + t) * 4608 + h * 128 + d0;
    if (mixer == 0) {
        const float lg = log1pf(-exp2f(-(5.f + 0.5f * dir) - (float)h));
        const float c = dir ? lg * (float)(64 - t) : lg * (float)(t + 1);
#pragma unroll
        for (int i = 0; i < 16; ++i) cum[t * 128 + d0 + i] = c;
        ld16(prow + 512, kv);
        __syncthreads();
    } else {
        float x[16]; ld16(prow + (dir ? 3072 : 2560), x);
#pragma unroll
        for (int i = 0; i < 16; ++i) { const float lbd = lbv[h * 128 + d0 + i]; const float f = lbd + (1.f - lbd) * sigmoidf_(x[i]); kv[i] = 1.f - f; cum[t * 128 + d0 + i] = __logf(f); }
        __syncthreads();
        { const int q = tid >> 7, d = tid & 127; float sacc = 0.f;
          if (dir == 0) { for (int r = 16 * q; r < 16 * q + 16; ++r) { sacc += cum[r * 128 + d]; cum[r * 128 + d] = sacc; } }
          else { for (int r = 16 * q + 15; r >= 16 * q; --r) { sacc += cum[r * 128 + d]; cum[r * 128 + d] = sacc; } }
          __syncthreads();
          float off = 0.f;
          if (dir == 0) { for (int qq = 0; qq < q; ++qq) off += cum[(16 * qq + 15) * 128 + d]; }
          else { for (int qq = q + 1; qq < 4; ++qq) off += cum[(16 * qq) * 128 + d]; }
          __syncthreads();
          for (int r = 16 * q; r < 16 * q + 16; ++r) cum[r * 128 + d] += off; }
        __syncthreads();
    }
}
DI void gla_load_vt(unsigned char* l, const u16* PROJ, int mixer, int h, int rowbase) {
    const int tid = tidx(), t = tid & 63, d0 = (tid >> 6) * 16;
    u16* vt = (u16*)(l + GL_VT);
    const u16* prow = PROJ + (size_t)(rowbase + t) * 4608 + (mixer ? 3584 : 1024) + h * 128 + d0;
    const u32x4 a = *(const u32x4*)prow, b = *(const u32x4*)(prow + 8);
    const unsigned wv[8] = {a.x, a.y, a.z, a.w, b.x, b.y, b.z, b.w};
#pragma unroll
    for (int i = 0; i < 8; ++i) { vt[(d0 + 2 * i) * GL_S72 + t] = (u16)(wv[i] & 0xffffu); vt[(d0 + 2 * i + 1) * GL_S72 + t] = (u16)(wv[i] >> 16); }
}
DI void gla_pass1_unit(const Params& p, int b, int lbj, int unit, unsigned char* l) {
    const int jc = unit % NCH, r0 = unit / NCH, dir = r0 & 1, h = (r0 >> 1) & 3, mixer = 1 - (r0 >> 3);
    const u16* PROJ = (const u16*)(p.ws + OFF_BIG + BO_PROJ);
    u16* GST = (u16*)(p.ws + OFF_BIG + BO_GST); float* GDEC = (float*)(p.ws + OFF_GDEC);
    const float* lbv = (const float*)(p.ws + OFF_LB) + lbj * 512;
    const int tid = tidx(), t = tid >> 3, d0 = (tid & 7) * 16, rowbase = gla_rowbase(b, jc);
    const int n = scan_idx(jc, dir);
    const size_t seq = (size_t)((mixer * 4 + h) * 2 + dir) * NCH + n;
    __syncthreads();
    float kv[16];
    gla_cum(l, PROJ, lbv, mixer, h, dir, rowbase, kv);
    gla_load_vt(l, PROJ, mixer, h, rowbase);
    const float* cum = (const float*)(l + GL_CUM); u16* kdt = (u16*)(l + GL_KDT);
    const int te = dir ? 0 : 63;
#pragma unroll
    for (int i = 0; i < 16; ++i) { const float e = cum[te * 128 + d0 + i]; kdt[(d0 + i) * GL_S72 + t] = f2bf(kv[i] * __expf(e - cum[t * 128 + d0 + i])); }
    if (tid < 128) GDEC[seq * 128 + tid] = __expf(cum[te * 128 + tid]);
    __syncthreads();
    const int w = tid >> 6, lane = tid & 63, l31 = lane & 31, hh = lane >> 5, er = w >> 1;
    const u16* vt = (const u16*)(l + GL_VT);
#pragma unroll
    for (int q = 0; q < 2; ++q) {
        const int dc = (w & 1) * 2 + q;
        f32x16 a;
#pragma unroll
        for (int i = 0; i < 16; ++i) a[i] = 0.f;
#pragma unroll
        for (int ks = 0; ks < 4; ++ks) {
            const bf16x8 af = *(const bf16x8*)(vt + (32 * er + l31) * GL_S72 + 16 * ks + 8 * hh);
            const bf16x8 bf = *(const bf16x8*)(kdt + (32 * dc + l31) * GL_S72 + 16 * ks + 8 * hh);
            a = MFMA32(af, bf, a);
        }
        u16* dst = GST + seq * 16384;
#pragma unroll
        for (int i = 0; i < 16; ++i) dst[(32 * er + crow32(i, hh)) * 128 + 32 * dc + l31] = f2bf(a[i]);
    }
}
DI void gla_scan(const Params& p) {
    u16* GST = (u16*)(p.ws + OFF_BIG + BO_GST); const float* GDEC = (const float*)(p.ws + OFF_GDEC);
    for (int gt = blockIdx.x * 512 + tidx(); gt < 16 * 8192; gt += gridDim.x * 512) {
    const int sq = gt >> 13, idx = (gt & 8191) * 2, d = idx & 127;
    unsigned* base = (unsigned*)(GST + (size_t)sq * NCH * 16384 + idx); const float* dec = GDEC + (size_t)sq * NCH * 128 + d;
    float s0 = 0.f, s1 = 0.f; asm volatile("" : "+v"(s0), "+v"(s1));
    for (int n0 = 0; n0 < NCH; n0 += 12) {
        unsigned kv[12]; float2 dc[12];
#pragma unroll
        for (int i = 0; i < 12; ++i) { kv[i] = base[(size_t)(n0 + i) * 8192]; dc[i] = *(const float2*)(dec + (size_t)(n0 + i) * 128); }
#pragma unroll
        for (int i = 0; i < 12; ++i) { base[(size_t)(n0 + i) * 8192] = pk2(s0, s1);
            s0 = dc[i].x * s0 + bflo(kv[i]); s1 = dc[i].y * s1 + bfhi(kv[i]); }
    }
    }
}
DI void gla_pass3_unit(const Params& p, int b, int lbj, int jodd, int unit, unsigned char* l, bool latent_only) {
    const int nch = latent_only ? 128 : NCH;
    const int jc = latent_only ? 4 + unit % 128 : unit % NCH, r0 = unit / nch, h = r0 & 3, mixer = 1 - (r0 >> 2);
    const u16* PROJ = (const u16*)(p.ws + OFF_BIG + BO_PROJ);
    const u16* GST = (const u16*)(p.ws + OFF_BIG + BO_GST);
    const float* lbv = (const float*)(p.ws + OFF_LB) + lbj * 512;
    u16* HB = (u16*)(p.ws + OFF_HB);
    const int tid = tidx(), t = tid >> 3, d0 = (tid & 7) * 16, rowbase = gla_rowbase(b, jc);
    const int w = tid >> 6, lane = tid & 63, l31 = lane & 31, hh = lane >> 5, tr = w >> 2, ec = w & 3;
    f32x16 oacc;
#pragma unroll
    for (int i = 0; i < 16; ++i) oacc[i] = 0.f;
    __syncthreads();
    gla_load_vt(l, PROJ, mixer, h, rowbase);
    float qv[16]; ld16(PROJ + (size_t)(rowbase + t) * 4608 + (mixer ? 2048 : 0) + h * 128 + d0, qv);
    for (int dir = 0; dir < 2; ++dir) {
        float kv[16];
        bf16x8 sfr[8];
        { const u16* S = GST + ((size_t)((mixer * 4 + h) * 2 + dir) * NCH + scan_idx(jc, dir)) * 16384 + (32 * ec + l31) * 128 + 8 * hh;
#pragma unroll
          for (int ks = 0; ks < 8; ++ks) sfr[ks] = *(const bf16x8*)(S + 16 * ks); }
        gla_cum(l, PROJ, lbv, mixer, h, dir, rowbase, kv);
        const float* cum = (const float*)(l + GL_CUM);
        u16* qt = (u16*)(l + GL_QT); u16* ktl = (u16*)(l + GL_KT); u16* qsl = (u16*)(l + GL_QS); u16* att = (u16*)(l + GL_ATT);
        const int tref = dir ? 32 : 31;
        {
            float fq_[16], fk_[16], fs_[16];
#pragma unroll
            for (int i = 0; i < 16; ++i) { const float c = cum[t * 128 + d0 + i], rf = cum[tref * 128 + d0 + i];
                fq_[i] = qv[i] * __expf(c - rf); fk_[i] = kv[i] * __expf(rf - c); fs_[i] = qv[i] * __expf(c); }
#pragma unroll
            for (int hf = 0; hf < 2; ++hf) { u32x4 wq, wk, ws;
                wq.x = pk2(fq_[8 * hf], fq_[8 * hf + 1]); wq.y = pk2(fq_[8 * hf + 2], fq_[8 * hf + 3]); wq.z = pk2(fq_[8 * hf + 4], fq_[8 * hf + 5]); wq.w = pk2(fq_[8 * hf + 6], fq_[8 * hf + 7]);
                wk.x = pk2(fk_[8 * hf], fk_[8 * hf + 1]); wk.y = pk2(fk_[8 * hf + 2], fk_[8 * hf + 3]); wk.z = pk2(fk_[8 * hf + 4], fk_[8 * hf + 5]); wk.w = pk2(fk_[8 * hf + 6], fk_[8 * hf + 7]);
                ws.x = pk2(fs_[8 * hf], fs_[8 * hf + 1]); ws.y = pk2(fs_[8 * hf + 2], fs_[8 * hf + 3]); ws.z = pk2(fs_[8 * hf + 4], fs_[8 * hf + 5]); ws.w = pk2(fs_[8 * hf + 6], fs_[8 * hf + 7]);
                *(u32x4*)(qt + t * GL_S136 + d0 + 8 * hf) = wq; *(u32x4*)(ktl + t * GL_S136 + d0 + 8 * hf) = wk; *(u32x4*)(qsl + t * GL_S136 + d0 + 8 * hf) = ws; }
        }
        __syncthreads();
        { const int tt = w >> 1;
#pragma unroll
          for (int q = 0; q < 2; ++q) { const int ts = (w & 1) * 2 + q;
            f32x4 a = (f32x4){0.f, 0.f, 0.f, 0.f};
#pragma unroll
            for (int ks = 0; ks < 4; ++ks) {
                const bf16x8 af = *(const bf16x8*)(qt + (16 * tt + (lane & 15)) * GL_S136 + 32 * ks + 8 * (lane >> 4));
                const bf16x8 bf = *(const bf16x8*)(ktl + (16 * ts + (lane & 15)) * GL_S136 + 32 * ks + 8 * (lane >> 4));
                a = MFMA16(af, bf, a); }
#pragma unroll
            for (int i = 0; i < 4; ++i) { const int trow = 16 * tt + 4 * (lane >> 4) + i, scol = 16 * ts + (lane & 15);
                const bool keep = dir ? (scol >= trow) : (scol <= trow);
                att[trow * GL_S72 + scol] = f2bf(keep ? a[i] : 0.f); } } }
        __syncthreads();
        const u16* vt = (const u16*)(l + GL_VT);
#pragma unroll
        for (int ks = 0; ks < 4; ++ks) {
            const bf16x8 af = *(const bf16x8*)(att + (32 * tr + l31) * GL_S72 + 16 * ks + 8 * hh);
            const bf16x8 bf = *(const bf16x8*)(vt + (32 * ec + l31) * GL_S72 + 16 * ks + 8 * hh);
            oacc = MFMA32(af, bf, oacc); }
#pragma unroll
        for (int ks = 0; ks < 8; ++ks) {
            const bf16x8 af = *(const bf16x8*)(qsl + (32 * tr + l31) * GL_S136 + 16 * ks + 8 * hh);
            oacc = MFMA32(af, sfr[ks], oacc); }
        __syncthreads();
    }
    float* ob = (float*)(l + GL_CUM);
#pragma unroll
    for (int i = 0; i < 16; ++i) ob[(32 * tr + crow32(i, hh)) * 132 + 32 * ec + l31] = oacc[i];
    __syncthreads();
    { float v[16]; float s = 0.f;
#pragma unroll
      for (int i = 0; i < 16; ++i) { v[i] = ob[t * 132 + d0 + i]; s += v[i]; }
      if (mixer == 0) { s += __shfl_xor(s, 1); s += __shfl_xor(s, 2); s += __shfl_xor(s, 4); const float mean = s * (1.f / 128.f);
#pragma unroll
          for (int i = 0; i < 16; ++i) v[i] -= mean; }
      float ss = 0.f;
#pragma unroll
      for (int i = 0; i < 16; ++i) ss += v[i] * v[i];
      ss += __shfl_xor(ss, 1); ss += __shfl_xor(ss, 2); ss += __shfl_xor(ss, 4);
      const float rstd = rsqrtf(ss * (1.f / 128.f) + EPS);
      const float* gn = (mixer ? p.in[30] : p.in[28]) + jodd * 512 + h * 128 + d0;
      float gt_[16]; ld16(PROJ + (size_t)(rowbase + t) * 4608 + (mixer ? 4096 : 1536) + h * 128 + d0, gt_);
      u32x4 o0, o1; float r[16];
#pragma unroll
      for (int i = 0; i < 16; ++i) r[i] = v[i] * rstd * gn[i] * siluf_(gt_[i]);
      o0.x = pk2(r[0], r[1]); o0.y = pk2(r[2], r[3]); o0.z = pk2(r[4], r[5]); o0.w = pk2(r[6], r[7]);
      o1.x = pk2(r[8], r[9]); o1.y = pk2(r[10], r[11]); o1.z = pk2(r[12], r[13]); o1.w = pk2(r[14], r[15]);
      u16* dst = HB + (size_t)(rowbase + t) * 1024 + mixer * 512 + h * 128 + d0;
      *(u32x4*)dst = o0; *(u32x4*)(dst + 8) = o1; }
}

#define XB_TMO      128
#define XB_XCNT(j)  (256  + 64 * (j))
#define XB_XSUB(j)  (1280 + 64 * (j))
#define XB_XGEN(j)  (2304 + 64 * (j))
#define XB_TOP      3328
#define XB_TOPGEN   3392
#define XCD_BAR_WORDS 3456
#define XB_SPIN_CAP (1u << 22)
DI unsigned xb_ld(unsigned* p)              { return __hip_atomic_load(p, __ATOMIC_RELAXED, __HIP_MEMORY_SCOPE_AGENT); }
DI unsigned xb_add(unsigned* p, unsigned v) { return __hip_atomic_fetch_add(p, v, __ATOMIC_RELAXED, __HIP_MEMORY_SCOPE_AGENT); }
DI unsigned xb_xcc_id() { return (unsigned)__builtin_amdgcn_s_getreg((3 << 11) | 20) & 0xFu; }
#define XB_SPIN(cond, bar) do { unsigned _sp = 0; while (cond) { __builtin_amdgcn_s_sleep(1); \
    if ((++_sp & 255u) == 0u) { if (xb_ld(&(bar)[XB_TMO])) break; if (_sp > XB_SPIN_CAP) { atomicAdd(&(bar)[XB_TMO], 1u); break; } } } } while (0)
struct XcdBarrier { unsigned* bar; unsigned x; volatile LAS unsigned* st; };
DI XcdBarrier xcd_barrier_post(unsigned* bar, volatile LAS unsigned* st) {
    XcdBarrier b; b.bar = bar; b.x = xb_xcc_id(); b.st = st;
    if (threadIdx.x == 0) (void)xb_add(&bar[XB_XCNT(b.x)], 1u);
    return b;
}
DI void xcd_barrier_complete(unsigned* bar, unsigned x, unsigned& nloc, unsigned& nx) {
    const unsigned G = gridDim.x * gridDim.y * gridDim.z;
    unsigned sum, cnt, mine, sp = 0u;
    for (;;) {
        sum = 0u; cnt = 0u; mine = 0u;
#pragma unroll
        for (unsigned j = 0; j < 16; ++j) { const unsigned c = xb_ld(&bar[XB_XCNT(j)]); sum += c; cnt += (c > 0u) ? 1u : 0u; mine = (j == x) ? c : mine; }
        if (sum == G) break;
        __builtin_amdgcn_s_sleep(1);
        if ((++sp & 255u) == 0u) { if (xb_ld(&bar[XB_TMO])) break; if (sp > XB_SPIN_CAP) { atomicAdd(&bar[XB_TMO], 1u); break; } }
    }
    nloc = mine > 0u ? mine : 1u; nx = cnt > 0u ? cnt : 1u;
}
DI void xcd_barrier(const XcdBarrier& b) {
    asm volatile("s_waitcnt vmcnt(0)" ::: "memory");
    __syncthreads();
    if (threadIdx.x == 0) {
        unsigned* bar = b.bar;
        __builtin_amdgcn_s_waitcnt(0);
        unsigned nloc = b.st[0], nx = b.st[1];
        if (nloc == 0u) { xcd_barrier_complete(bar, b.x, nloc, nx); b.st[0] = nloc; b.st[1] = nx; }
        const unsigned old = xb_add(&bar[XB_XSUB(b.x)], 1u);
        const unsigned gen = old / nloc;
        if (old + 1u == (gen + 1u) * nloc) {
            __builtin_amdgcn_fence(__ATOMIC_RELEASE, "agent");
            asm volatile("s_waitcnt vmcnt(0)" ::: "memory");
            const unsigned og = xb_add(&bar[XB_TOP], 1u);
            const unsigned tg = og / nx;
            if (og + 1u == (tg + 1u) * nx) xb_add(&bar[XB_TOPGEN], 1u);
            else XB_SPIN(xb_ld(&bar[XB_TOPGEN]) == tg, bar);
            __builtin_amdgcn_fence(__ATOMIC_ACQUIRE, "agent");
            xb_add(&bar[XB_XGEN(b.x)], 1u);
            asm volatile("s_waitcnt vmcnt(0)" ::: "memory");
        } else {
            XB_SPIN(xb_ld(&bar[XB_XGEN(b.x)]) == gen, bar);
            __builtin_amdgcn_fence(__ATOMIC_ACQUIRE, "agent");
            asm volatile("s_waitcnt vmcnt(0)" ::: "memory");
        }
    }
    __syncthreads();
}

__global__ void __launch_bounds__(512) fwd_megakernel(Params p0) {
    Params p = p0;
    extern __shared__ __attribute__((aligned(16))) unsigned char lds_raw[];
    LAS unsigned char* lds = (LAS unsigned char*)lds_raw;
    cg::grid_group grid = cg::this_grid();
    volatile LAS unsigned* xst = (volatile LAS unsigned*)(lds + 147440);
    if (threadIdx.x < 4) xst[threadIdx.x] = 0u;
    __syncthreads();
    const XcdBarrier xb = xcd_barrier_post((unsigned*)(p.ws + OFF_BAR), xst);
#define GSYNC() do { for (int r_ = 0; r_ < REP(1); ++r_) xcd_barrier(xb); } while (0)
    unsigned char* ws = p.ws;
    float* mod = (float*)(ws + OFF_MOD);
    float* XRES = (float*)(ws + OFF_XRES);
    u16* HB = (u16*)(ws + OFF_HB);
    unsigned char* BIG = ws + OFF_BIG;
    const int G = gridDim.x, bid = blockIdx.x;

    for (int r_ = 0; r_ < REP(32); ++r_) prep_phase(p, (float*)lds_raw);
    if (p.ws == nullptr) grid.sync();
    GSYNC();
    { const float* mp = (const float*)(p.ws + OFF_MODP); float* md = (float*)(p.ws + OFF_MOD);
      for (int i = bid * 512 + tidx(); i < 4 * 3 * 6144; i += G * 512) { float a = 0.f;
#pragma unroll
        for (int k = 0; k < 16; ++k) a += mp[(size_t)k * (4 * 3 * 6144) + i];
        md[i] = a; } }
    GSYNC();

    for (int li = 0; li < 4; ++li) {
        asm volatile("" : "+s"(p.ws));
        ws = p.ws; mod = (float*)(ws + OFF_MOD); XRES = (float*)(ws + OFF_XRES); HB = (u16*)(ws + OFF_HB); BIG = ws + OFF_BIG;
        const float* srcLat = li == 0 ? p.in[0] : XRES;
        const float* srcCtx = li == 0 ? p.in[2] : XRES + (size_t)NLAT * 1024;
        const float* modl = mod + li * 3 * 6144;
        const int j = li >> 1;
        for (int r_ = 0; r_ < REP(16); ++r_) { norm_rows(srcLat, srcCtx, p.in[6] + li * 1024, modl, 1024, 0, HB, li > 0 ? (float*)(BIG + 150000000) : nullptr, 11, mod + (li - 1) * 3 * 6144 + 2 * 6144 + 5 * 1024, XRES);
        conv_ffn_weights(p, li, (float*)lds_raw); }
        GSYNC();
        if ((li & 1) == 0) {
            float* ssq = (float*)(ws + OFF_SSQ); float* sskv = ssq + (size_t)NTOK * 8;
            u16* U = (u16*)(BIG + BE_U); u16* CQKV = (u16*)(BIG + BE_CQKV); u16* Q = (u16*)(BIG + BE_Q); u16* KC = (u16*)(BIG + BE_KC); u16* VT = (u16*)(BIG + BE_VT); u16* Z = (u16*)(BIG + BE_Z);
            { EpiInEven E{U, CQKV, KC, ssq, sskv, (const float*)(ws + OFF_RMLA)};
              run_gemm(lds, HB, 1024, (const u16*)(ws + OFF_WMIX + WE_IN), 1024, NTOK, 1024, 1024, E);
              if (REP(2) > 1) { EpiInEven E2{U, CQKV, KC, (float*)(BIG + 150000000), (float*)(BIG + 150000000), (const float*)(ws + OFF_RMLA)}; run_gemm(lds, HB, 1024, (const u16*)(ws + OFF_WMIX + WE_IN), 1024, NTOK, 1024, 1024, E2); } }
            GSYNC();
            for (int r_ = 0; r_ < REP(8); ++r_) for (int u = bid; u < 2 * NCH * 4; u += G) s5_pass1_unit(p, j, u, lds_raw);
            GSYNC();
            s5_carry_scan(p, j, G > 16 ? G - 16 : 0);
            { EpiQ E{Q, ssq, (const float*)(ws + OFF_RMLA)};
              for (int r_ = 0; r_ < REP(2); ++r_) run_gemm(lds, CQKV, 384, (const u16*)(ws + OFF_WMIX + WE_UQ), 256, NTOK, 768, 256, E); }
            { EpiKV E{KC, VT, sskv};
              for (int r_ = 0; r_ < REP(2); ++r_) run_gemm(lds, CQKV + 128, 384, (const u16*)(ws + OFF_WMIX + WE_UKV), 256, NTOK, 1024, 256, E); }
            GSYNC();
            for (int r_ = 0; r_ < 2; ++r_) for (int u = bid; u < 272 + 1056; u += G) {
                if (r_ == 1 && !(u < 272 ? REP(4) > 1 : REP(8) > 1)) continue;
                if (u < 256) { const int bh = (u & 7) * 2 + (u >> 7), qb = (u >> 3) & 15;
                    __syncthreads();
                    attn_unit64(lds, Q + ((size_t)bh * SEQ + qb * 512) * 96, KC + (size_t)bh * LK * 96, VT + (size_t)bh * 64 * LK, LK / 64,
                                HB + (size_t)((bh >> 3) * SEQ + qb * 512) * 1024 + 512 + (bh & 7) * 64);
                } else if (u < 272) { const int bh = u - 256;
                    __syncthreads();
                    attn_unit(lds, Q + (size_t)NLAT * 768 + (size_t)bh * CTXL * 96, KC + (size_t)bh * LK * 96, VT + (size_t)bh * 64 * LK, CTXL / 64,
                              HB + (size_t)(NLAT + (bh >> 3) * CTXL) * 1024 + 512 + (bh & 7) * 64);
                } else s5_pass2_unit(p, j, u - 272, lds_raw);
            }
            GSYNC();
            { EpiGlu E{Z, HB};
              for (int r_ = 0; r_ < REP(2); ++r_) run_gemm(lds, Z, 512, (const u16*)(ws + OFF_WMIX + WE_GLU), 512, NTOK, 512, 512, E); }
            GSYNC();
            { EpiRes E{srcLat, srcCtx, modl + 2048, XRES, (float*)(BIG + 150000000)};
              run_gemm_mixed(lds, HB, 1024, (const u16*)(ws + OFF_WMIX + WE_OUT), 1024, 1024, 1024, E);
              if (REP(2) > 1) { EpiRes E2{srcLat, srcCtx, modl + 2048, (float*)(BIG + 150000000), (float*)(BIG + 150000000)}; run_gemm(lds, HB, 1024, (const u16*)(ws + OFF_WMIX + WE_OUT), 1024, NTOK, 1024, 1024, E2); } }
            GSYNC();
        } else {
            u16* PROJ = (u16*)(BIG + BO_PROJ);
            { EpiInOdd E{PROJ, (const float*)(ws + OFF_RRET)};
              for (int r_ = 0; r_ < REP(2); ++r_) run_gemm(lds, HB, 1024, (const u16*)(ws + OFF_WMIX + WO_IN), 1024, NTOK, 4608, 1024, E); }
            GSYNC();
            for (int b = 0; b < 2; ++b) {
                for (int r_ = 0; r_ < REP(64); ++r_) for (int u = bid; u < 16 * NCH; u += G) gla_pass1_unit(p, b, j, u, lds_raw);
                GSYNC();
                gla_scan(p);
                GSYNC();
                for (int r_ = 0; r_ < REP(128); ++r_) for (int u = bid; u < 8 * (li == 3 ? 128 : NCH); u += G) gla_pass3_unit(p, b, j, j, u, lds_raw, li == 3);
                GSYNC();
            }
            { EpiRes E{srcLat, srcCtx, modl + 2048, XRES, (float*)(BIG + 150000000)};
              { if (li == 3) run_gemm(lds, HB, 1024, (const u16*)(ws + OFF_WMIX + WO_OUT), 1024, NLAT, 1024, 1024, E); else run_gemm_mixed(lds, HB, 1024, (const u16*)(ws + OFF_WMIX + WO_OUT), 1024, 1024, 1024, E); }
              if (REP(2) > 1) { EpiRes E2{srcLat, srcCtx, modl + 2048, (float*)(BIG + 150000000), (float*)(BIG + 150000000)}; run_gemm(lds, HB, 1024, (const u16*)(ws + OFF_WMIX + WO_OUT), 1024, NTOK, 1024, 1024, E2); } }
            GSYNC();
        }
        for (int r_ = 0; r_ < REP(16); ++r_) { norm_rows(XRES, srcCtx, p.in[7] + li * 1024, modl, 4 * 1024, 3 * 1024, HB, li < 3 ? (float*)(BIG + 150000000) : nullptr, 4, modl + 2 * 6144 + 2048, XRES);
        if (li < 3) conv_mixer_weights(p, li + 1, (float*)lds_raw); }
        GSYNC();
        { EpiFFN1 E{(u16*)(BIG)};
          for (int r_ = 0; r_ < REP(2); ++r_) { if (li == 3) run_gemm(lds, HB, 1024, (const u16*)(ws + OFF_WFFN + WF_13), 1024, NLAT, 5632, 1024, E); else run_gemm(lds, HB, 1024, (const u16*)(ws + OFF_WFFN + WF_13), 1024, NTOK, 5632, 1024, E); } }
        GSYNC();
        { EpiRes E{XRES, XRES + (size_t)NLAT * 1024, modl + 5 * 1024, XRES, (float*)(BIG + 150000000)};
          { if (li == 3) run_gemm(lds, (const u16*)BIG, DFF, (const u16*)(ws + OFF_WFFN + WF_2), DFF, NLAT, 1024, DFF, E); else run_gemm_mixed(lds, (const u16*)BIG, DFF, (const u16*)(ws + OFF_WFFN + WF_2), DFF, 1024, DFF, E); }
          if (REP(2) > 1) { EpiRes E2{XRES, XRES + (size_t)NLAT * 1024, modl + 5 * 1024, (float*)(BIG + 150000000), (float*)(BIG + 150000000)}; run_gemm(lds, (const u16*)BIG, DFF, (const u16*)(ws + OFF_WFFN + WF_2), DFF, NTOK, 1024, DFF, E2); } }
        GSYNC();
    }
    final_norm_rows(XRES, p.in[31], p.out);
}

extern "C" void kernel_launch(void* const* d_in, const int* in_sizes, int n_in, void* d_out, int out_size,
                              void* d_ws, size_t ws_size, hipStream_t stream) {
    constexpr size_t kDynLds = 147456;
    static int grid_blocks = 0;
    if (!grid_blocks) {
        int dev = 0, cus = 0, per_cu = 0;
        (void)hipGetDevice(&dev);
        (void)hipDeviceGetAttribute(&cus, hipDeviceAttributeMultiprocessorCount, dev);
        (void)hipFuncSetAttribute((const void*)fwd_megakernel, hipFuncAttributeMaxDynamicSharedMemorySize, (int)kDynLds);
        (void)hipOccupancyMaxActiveBlocksPerMultiprocessor(&per_cu, fwd_megakernel, 512, kDynLds);
        if (per_cu > 1) per_cu = 1;
        grid_blocks = cus * per_cu;
        if (ws_size < WS_NEED) fprintf(stderr, "workspace too small: %zu < %zu\n", ws_size, (size_t)WS_NEED);
    }
    Params p{};
    for (int i = 0; i < 32; ++i) p.in[i] = (const float*)d_in[i];
    p.out = (float*)d_out; p.ws = (unsigned char*)d_ws;
    (void)hipMemsetAsync((unsigned char*)d_ws + OFF_BAR, 0, 16384, stream);
    void* args[] = {&p};
    hipError_t e = hipLaunchCooperativeKernel((void*)fwd_megakernel, dim3(grid_blocks), dim3(512), args, kDynLds, stream);
    if (e != hipSuccess) fprintf(stderr, "cooperative launch failed: %s (grid %d)\n", hipGetErrorString(e), grid_blocks);
}
```

```cpp
#include <hip/hip_runtime.h>
#include <hip/hip_cooperative_groups.h>
#include <cstdio>
namespace cg = cooperative_groups;
#ifndef PROBE
#define PROBE 0
#endif
#define REP(mask) ((PROBE & (mask)) ? 2 : 1)
#define DI __device__ __forceinline__
#define LAS __attribute__((address_space(3)))
typedef unsigned short u16;
typedef short bf16x8 __attribute__((ext_vector_type(8)));
typedef float f32x4 __attribute__((ext_vector_type(4)));
typedef float f32x16 __attribute__((ext_vector_type(16)));
typedef unsigned u32x4 __attribute__((ext_vector_type(4)));
typedef unsigned u32x2 __attribute__((ext_vector_type(2)));

constexpr int DM = 1024, SEQ = 8192, CTXL = 256, NLAT = 16384, NCTX = 512, NTOK = 16896, DFF = 2816, LK = 8448;
constexpr int NCH = 132;
constexpr float EPS = 1e-6f;

constexpr size_t al256(size_t x) { return (x + 255) & ~(size_t)255; }
constexpr size_t OFF_MOD = 0;
constexpr size_t OFF_RMLA = al256(OFF_MOD + 4 * 3 * 6144 * 4);
constexpr size_t OFF_RRET = al256(OFF_RMLA + 8192 * 16 * 2 * 4);
constexpr size_t OFF_LB = al256(OFF_RRET + 8192 * 64 * 2 * 4);
constexpr size_t OFF_SAB = al256(OFF_LB + 2 * 512 * 4);
constexpr size_t OFF_SA64 = al256(OFF_SAB + 2 * 2 * 2048 * 8);
constexpr size_t OFF_SBB = al256(OFF_SA64 + 2 * 2 * 2048 * 8);
constexpr size_t OFF_SCC = al256(OFF_SBB + 2 * 2 * 2048 * 16 * 8);
constexpr size_t OFF_SSQ = al256(OFF_SCC + 2 * 2 * 32 * 16 * 128 * 2);
constexpr size_t OFF_GDEC = al256(OFF_SSQ + (size_t)NTOK * 12 * 4);
constexpr size_t OFF_WMIX = al256(OFF_GDEC + 2 * 4 * 2 * NCH * 128 * 4);
constexpr size_t WMIX_BYTES = 9437184 + 2097152;
constexpr size_t OFF_WFFN = al256(OFF_WMIX + WMIX_BYTES);
constexpr size_t WFFN_BYTES = (size_t)5632 * 1024 * 2 + (size_t)1024 * 2816 * 2;
constexpr size_t OFF_XRES = al256(OFF_WFFN + WFFN_BYTES);
constexpr size_t OFF_HB = al256(OFF_XRES + (size_t)NTOK * 1024 * 4);
constexpr size_t OFF_BIG = al256(OFF_HB + (size_t)NTOK * 1024 * 2);
constexpr size_t BE_U = 0;
constexpr size_t BE_CQKV = al256(BE_U + (size_t)NTOK * 512 * 2);
constexpr size_t BE_Q = al256(BE_CQKV + (size_t)NTOK * 384 * 2);
constexpr size_t BE_KC = al256(BE_Q + (size_t)NTOK * 768 * 2);
constexpr size_t BE_VT = al256(BE_KC + (size_t)2 * 8 * LK * 96 * 2);
constexpr size_t BE_Z = al256(BE_VT + (size_t)2 * 8 * 64 * LK * 2);
constexpr size_t BE_S5E = al256(BE_Z + (size_t)NTOK * 512 * 2);
constexpr size_t BO_PROJ = 0;
constexpr size_t BO_GST = al256(BO_PROJ + (size_t)NTOK * 4608 * 2);
constexpr size_t BIG_BYTES = BO_GST + (size_t)2 * 4 * 2 * NCH * 16384 * 2;
constexpr size_t OFF_BAR = al256(OFF_BIG + BIG_BYTES);
constexpr size_t OFF_MODP = OFF_BAR + 16384;
constexpr size_t WS_NEED = OFF_MODP + (size_t)16 * 4 * 3 * 6144 * 4;
constexpr size_t WE_IN = 0, WE_OUT = 2097152, WE_GLU = 4194304, WE_UQ = 4718592, WE_UKV = 5242880;
constexpr size_t WO_IN = 0, WO_OUT = 9437184;
constexpr size_t WF_13 = 0, WF_2 = (size_t)5632 * 1024 * 2;

struct Params { const float* in[32]; float* out; unsigned char* ws; };

DI int tidx() { int t = threadIdx.x; asm volatile("" : "+v"(t)); return t; }
typedef float f32x2 __attribute__((ext_vector_type(2)));
typedef __bf16 bf16x2_t __attribute__((ext_vector_type(2)));
DI unsigned pk2(float lo, float hi) { const f32x2 v = {lo, hi}; const bf16x2_t b = __builtin_convertvector(v, bf16x2_t); return __builtin_bit_cast(unsigned, b); }
DI u16 f2bf(float x) { return (u16)(pk2(x, x) & 0xffffu); }
DI float bf2f(u16 b) { return __uint_as_float(((unsigned)b) << 16); }
DI float bflo(unsigned w) { return __uint_as_float(w << 16); }
DI float bfhi(unsigned w) { return __uint_as_float(w & 0xffff0000u); }
DI float sigmoidf_(float x) { return 1.f / (1.f + __expf(-x)); }
DI float siluf_(float x) { return x / (1.f + __expf(-x)); }
DI float gelu_tanh(float y) { float t = 0.7978845608028654f * (y + 0.044715f * y * y * y); return 0.5f * y * (1.f + tanhf(t)); }
DI int tok_b(int row) { return row < NLAT ? (row >> 13) : ((row - NLAT) >> 8); }
DI int tok_bidx(int row) { return row < NLAT ? (row >> 13) : 2; }
#define MFMA32(a, b, c) __builtin_amdgcn_mfma_f32_32x32x16_bf16((a), (b), (c), 0, 0, 0)
#define MFMA16(a, b, c) __builtin_amdgcn_mfma_f32_16x16x32_bf16((a), (b), (c), 0, 0, 0)
DI int scan_idx(int jc, int dir) { return dir ? (jc < 4 ? 3 - jc : 135 - jc) : jc; }
DI int crow32(int i, int hh) { return (i & 3) + 8 * (i >> 2) + 4 * hh; }

namespace pg8 {
constexpr int BM = 256, BK = 64, HALF = 128, HTB = HALF * BK * 2, NXCD = 8, WGM = 8;
DI int lds_byte(int r, int c) { const int st = (r >> 4) * 2 + (c >> 5), rr = r & 15, cc = c & 31, ob = rr * 64 + cc * 2; return st * 1024 + (ob ^ (((ob >> 9) & 1) << 5)); }
DI void stage_rc(int b, int& R, int& C) { const int st = b / 1024, sb = b % 1024, swz = sb ^ (((sb >> 9) & 1) << 5); R = (st >> 1) * 16 + swz / 64; C = (st & 1) * 32 + (swz % 64) / 2; }
struct Unit { int pm, pn, ks; };
struct Gemm { const u16* A; const u16* Bt; int M, N, K, lda, ldb; };
struct StaticOrder {
    int nM, nN, nwg, G, c;
    DI void init(int M, int N, int G_, int c_) { nM = M / BM; nN = N / BM; nwg = nM * nN; G = G_; c = c_; }
    DI bool next(int i, Unit& u) const {
        const long L = (long)i * G + c; if (L >= nwg) return false;
        int wgid = (int)L; { const int q = nwg / NXCD, r = nwg % NXCD, xcd = wgid % NXCD, off = wgid / NXCD; wgid = (xcd < r ? xcd * (q + 1) : r * (q + 1) + (xcd - r) * q) + off; }
        const int nig = WGM * nN, gid = wgid / nig, fm = gid * WGM, gsz = (nM - fm) < WGM ? (nM - fm) : WGM;
        u.pm = fm + ((wgid % nig) % gsz); u.pn = (wgid % nig) / gsz; u.ks = -1; return true;
    }
};
struct MixedOrder {
    StaticOrder lat; int nN, KS, nlat, ntot;
    DI void init(int N, int KS_, int G_, int c_) { lat.init(16384, N, G_, c_); nN = N / BM; KS = KS_; nlat = lat.nwg; ntot = nlat + 2 * nN * KS; }
    DI bool next(int i, Unit& u) const {
        const long L = (long)i * lat.G + lat.c; if (L >= ntot) return false;
        if (L < nlat) return lat.next(i, u);
        const int e = (int)L - nlat, r = e / KS; u.ks = e - r * KS; u.pn = r % nN; u.pm = 64 + r / nN; return true;
    }
};
template <class Epi, class Sched>
DI void gemm_phase(LAS unsigned char* lds, const Gemm g, const Sched& S, const Epi& E) {
    const int tid = tidx(), wid = __builtin_amdgcn_readfirstlane(tid >> 6), lane = tid & 63, wr = wid >> 2, wc = wid & 3, fr = lane & 15, fq = lane >> 4;
    int K = g.K; asm volatile("" : "+s"(K)); const int ntFull = K / BK;
    unsigned voffA[2], voffB[2];
#pragma unroll
    for (int i = 0; i < 2; ++i) { int R, C; stage_rc(tid * 16 + i * 8192, R, C);
        voffA[i] = (unsigned)(R * g.lda + C) * 2u; voffB[i] = (unsigned)(R * g.ldb + C) * 2u; }
    const size_t kstep = (size_t)(BK * 2);
    const size_t hstepA = (size_t)HALF * g.lda * 2, hstepB = (size_t)HALF * g.ldb * 2;
    const size_t tstepA = 2 * hstepA, tstepB = 2 * hstepB;
    const unsigned ldsw = (unsigned)wid * 1024u;
    const int aoff = lds_byte(wr * 64 + fr, fq * 8), boff = lds_byte(wc * 32 + fr, fq * 8);
#define PG8_SA(b, h) (((b) * 2 + (h)) * HTB)
#define PG8_SB(b, h) ((4 + (b) * 2 + (h)) * HTB)
#define PG8_STAGE(bufoff, gbase, voff) do { _Pragma("unroll") for (int _i = 0; _i < 2; ++_i) \
        __builtin_amdgcn_global_load_lds((const unsigned*)((const char*)(gbase) + (voff)[_i]), (LAS unsigned*)(lds + (bufoff) + ldsw + _i * 8192), 16, 0, 0); } while (0)
#define PG8_LDA(dst, b, h) do { _Pragma("unroll") for (int m = 0; m < 4; ++m) _Pragma("unroll") for (int k = 0; k < 2; ++k) dst[m][k] = *(const LAS bf16x8*)(lds + PG8_SA(b, h) + aoff + m * 2048 + k * 1024); } while (0)
#define PG8_LDB(dst, b, h) do { _Pragma("unroll") for (int n = 0; n < 2; ++n) _Pragma("unroll") for (int k = 0; k < 2; ++k) dst[n][k] = *(const LAS bf16x8*)(lds + PG8_SB(b, h) + boff + n * 2048 + k * 1024); } while (0)
#define PG8_MMA(ai, bj, At, Bt) do { __builtin_amdgcn_s_setprio(1); _Pragma("unroll") for (int m = 0; m < 4; ++m) _Pragma("unroll") for (int n = 0; n < 2; ++n) _Pragma("unroll") for (int k = 0; k < 2; ++k) \
        acc[ai][bj][m][n] = __builtin_amdgcn_mfma_f32_16x16x32_bf16(Bt[n][k], At[m][k], acc[ai][bj][m][n], 0, 0, 0); __builtin_amdgcn_s_setprio(0); } while (0)
#define PG8_WAIT_V(n) asm volatile("s_waitcnt vmcnt(" #n ")" ::: "memory")
#define PG8_WAIT_L(n) asm volatile("s_waitcnt lgkmcnt(" #n ")" ::: "memory")
#define PG8_BAR __builtin_amdgcn_s_barrier()
#define PG8_SCHED __builtin_amdgcn_sched_barrier(0)
    Unit cur, nxt; int ui = 0;
    if (!S.next(0, cur)) return;
    f32x4 acc[2][2][4][2];
#pragma unroll
    for (int a = 0; a < 2; ++a)
#pragma unroll
        for (int b = 0; b < 2; ++b)
#pragma unroll
            for (int m = 0; m < 4; ++m)
#pragma unroll
                for (int n = 0; n < 2; ++n) acc[a][b][m][n] = (f32x4){0.f, 0.f, 0.f, 0.f};
    bf16x8 At[4][2], B0[2][2], B1[2][2];
    const char* cA = (const char*)g.A + (size_t)cur.pm * tstepA + (cur.ks >= 0 ? cur.ks * 512 : 0); const char* cB = (const char*)g.Bt + (size_t)cur.pn * tstepB + (cur.ks >= 0 ? cur.ks * 512 : 0);
    int nt = cur.ks >= 0 ? 4 : ntFull;
    PG8_STAGE(PG8_SB(0, 0), cB, voffB); PG8_STAGE(PG8_SA(0, 0), cA, voffA); PG8_STAGE(PG8_SB(0, 1), cB + hstepB, voffB); PG8_STAGE(PG8_SA(0, 1), cA + hstepA, voffA);
    if (wr == 1) PG8_BAR;
    PG8_WAIT_V(4); PG8_BAR;
    PG8_STAGE(PG8_SB(1, 0), cB + kstep, voffB); PG8_STAGE(PG8_SA(1, 0), cA + kstep, voffA); PG8_STAGE(PG8_SB(1, 1), cB + hstepB + kstep, voffB);
    PG8_WAIT_V(6); PG8_BAR;
    for (;;) {
        const bool has_next = S.next(ui + 1, nxt);
        const char* nA = has_next ? (const char*)g.A + (size_t)nxt.pm * tstepA + (nxt.ks >= 0 ? nxt.ks * 512 : 0) : cA; const char* nB = has_next ? (const char*)g.Bt + (size_t)nxt.pn * tstepB + (nxt.ks >= 0 ? nxt.ks * 512 : 0) : cB;
        for (int t = 0; t < nt; t += 2) {
            const bool last = (t == nt - 2);
            const char* a1 = cA + (size_t)(t + 1) * kstep;
            const char* a2 = last ? nA : cA + (size_t)(t + 2) * kstep; const char* b2 = last ? nB : cB + (size_t)(t + 2) * kstep;
            const char* a3 = a2 + kstep; const char* b3 = b2 + kstep;
            PG8_LDB(B0, 0, 0); PG8_SCHED; PG8_LDA(At, 0, 0); PG8_STAGE(PG8_SA(1, 1), a1 + hstepA, voffA);
            PG8_WAIT_L(8); PG8_BAR; PG8_WAIT_L(0); PG8_MMA(0, 0, At, B0); PG8_BAR; PG8_SCHED;
            PG8_LDB(B1, 0, 1); PG8_STAGE(PG8_SB(0, 0), b2, voffB);
            PG8_BAR; PG8_WAIT_L(0); PG8_MMA(0, 1, At, B1); PG8_BAR;
            PG8_LDA(At, 0, 1); PG8_STAGE(PG8_SA(0, 0), a2, voffA);
            PG8_BAR; PG8_WAIT_L(0); PG8_MMA(1, 0, At, B0); PG8_BAR; PG8_SCHED;
            PG8_STAGE(PG8_SB(0, 1), b2 + hstepB, voffB);
            PG8_WAIT_V(6); PG8_BAR; PG8_MMA(1, 1, At, B1); PG8_BAR;
            PG8_LDB(B0, 1, 0); PG8_SCHED; PG8_LDA(At, 1, 0); PG8_STAGE(PG8_SA(0, 1), a2 + hstepA, voffA);
            PG8_WAIT_L(8); PG8_BAR; PG8_WAIT_L(0); PG8_MMA(0, 0, At, B0); PG8_BAR; PG8_SCHED;
            PG8_LDB(B1, 1, 1); PG8_STAGE(PG8_SB(1, 0), b3, voffB);
            PG8_BAR; PG8_WAIT_L(0); PG8_MMA(0, 1, At, B1); PG8_BAR;
            PG8_LDA(At, 1, 1); PG8_STAGE(PG8_SA(1, 0), a3, voffA);
            PG8_BAR; PG8_WAIT_L(0); PG8_MMA(1, 0, At, B0); PG8_BAR; PG8_SCHED;
            PG8_STAGE(PG8_SB(1, 1), b3 + hstepB, voffB);
            PG8_WAIT_V(6); PG8_BAR; PG8_MMA(1, 1, At, B1); PG8_BAR;
        }
        { int fr2 = fr, fq2 = fq; asm volatile("" : "+v"(fr2), "+v"(fq2)); E(acc, cur, wr, wc, fr2, fq2); }
        if (!has_next) break;
#pragma unroll
        for (int a = 0; a < 2; ++a)
#pragma unroll
            for (int b = 0; b < 2; ++b)
#pragma unroll
                for (int m = 0; m < 4; ++m)
#pragma unroll
                    for (int n = 0; n < 2; ++n) acc[a][b][m][n] = (f32x4){0.f, 0.f, 0.f, 0.f};
        cur = nxt; cA = nA; cB = nB; ++ui; nt = cur.ks >= 0 ? 4 : ntFull;
    }
    PG8_WAIT_V(0);
    if (wr == 0) PG8_BAR;
    PG8_BAR;
#undef PG8_SA
#undef PG8_SB
#undef PG8_STAGE
#undef PG8_LDA
#undef PG8_LDB
#undef PG8_MMA
#undef PG8_WAIT_V
#undef PG8_WAIT_L
#undef PG8_BAR
#undef PG8_SCHED
}
}
using pg8::Unit;
typedef f32x4 AccT[2][2][4][2];
#define EPI_ROW(u, ai, m) ((u).pm * 256 + (ai) * 128 + wr * 64 + (m) * 16 + fr)
#define EPI_COLBASE(u, bj) ((u).pn * 256 + (bj) * 128 + wc * 32)

template <class Epi>
DI void run_gemm(LAS unsigned char* lds, const u16* A, int lda, const u16* Bt, int ldb, int M, int N, int K, const Epi& E) {
    pg8::Gemm g; g.A = A; g.Bt = Bt; g.M = M; g.N = N; g.K = K; g.lda = lda; g.ldb = ldb;
    pg8::StaticOrder S; S.init(M, N, (int)gridDim.x, (int)blockIdx.x);
    pg8::gemm_phase<Epi, pg8::StaticOrder>(lds, g, S, E);
    __syncthreads();
}
template <class Epi>
DI void run_gemm_mixed(LAS unsigned char* lds, const u16* A, int lda, const u16* Bt, int ldb, int N, int K, const Epi& E) {
    pg8::Gemm g; g.A = A; g.Bt = Bt; g.M = NTOK; g.N = N; g.K = K; g.lda = lda; g.ldb = ldb;
    pg8::MixedOrder S; S.init(N, K / 256, (int)gridDim.x, (int)blockIdx.x);
    pg8::gemm_phase<Epi, pg8::MixedOrder>(lds, g, S, E);
    __syncthreads();
}

DI void rope4(f32x4& v, const float* cs  ) {
    const f32x4 t = *(const f32x4*)cs;
    const float a0 = v[0] * t[0] - v[1] * t[1], a1 = v[0] * t[1] + v[1] * t[0];
    const float b0 = v[2] * t[2] - v[3] * t[3], b1 = v[2] * t[3] + v[3] * t[2];
    v = (f32x4){a0, a1, b0, b1};
}
DI u32x2 pack4(const f32x4& v) { u32x2 r; r.x = pk2(v[0], v[1]); r.y = pk2(v[2], v[3]); return r; }

struct EpiInEven {
    u16* U; u16* CQKV; u16* KC; float* ssq; float* sskv; const float* rope;
    DI void operator()(const AccT& acc, const Unit& u, int wr, int wc, int fr, int fq) const {
#pragma unroll
        for (int ai = 0; ai < 2; ++ai)
#pragma unroll
            for (int m = 0; m < 4; ++m) {
                const int row = EPI_ROW(u, ai, m);
#pragma unroll
                for (int bj = 0; bj < 2; ++bj) {
                    const int cb = EPI_COLBASE(u, bj);
                    if (cb < 512) {
#pragma unroll
                        for (int n = 0; n < 2; ++n) *(u32x2*)(U + (size_t)row * 512 + cb + n * 16 + 4 * fq) = pack4(acc[ai][bj][m][n]);
                    } else if (cb < 896) {
                        float ss = 0.f;
#pragma unroll
                        for (int n = 0; n < 2; ++n) { const f32x4 v = acc[ai][bj][m][n];
                            *(u32x2*)(CQKV + (size_t)row * 384 + (cb - 512) + n * 16 + 4 * fq) = pack4(v);
                            ss += v[0] * v[0] + v[1] * v[1] + v[2] * v[2] + v[3] * v[3]; }
                        ss += __shfl_xor(ss, 16); ss += __shfl_xor(ss, 32);
                        if (fq == 0) { if (cb < 768) ssq[(size_t)row * 8 + ((cb - 512) >> 5)] = ss; else sskv[(size_t)row * 4 + ((cb - 768) >> 5)] = ss; }
                    } else if (cb == 896) {
                        const int b = tok_b(row);
                        const int pos = row < NLAT ? 256 + (row & 8191) : ((row - NLAT) & 255);
#pragma unroll
                        for (int n = 0; n < 2; ++n) { f32x4 v = acc[ai][bj][m][n]; const int d0 = n * 16 + 4 * fq;
                            if (row < NLAT) rope4(v, rope + ((size_t)(row & 8191) * 16 + (d0 >> 1)) * 2);
                            const u32x2 w = pack4(v);
#pragma unroll
                            for (int h = 0; h < 8; ++h) *(u32x2*)(KC + ((size_t)(b * 8 + h) * LK + pos) * 96 + 64 + d0) = w; }
                    }
                }
            }
    }
};

struct EpiQ {
    u16* Q; const float* ssq; const float* rope;
    DI void operator()(const AccT& acc, const Unit& u, int wr, int wc, int fr, int fq) const {
        const float qs = 0.10206207261596577f * 1.4426950408889634f;
#pragma unroll
        for (int ai = 0; ai < 2; ++ai)
#pragma unroll
            for (int m = 0; m < 4; ++m) {
                const int row = EPI_ROW(u, ai, m);
                const f32x4 sa = *(const f32x4*)(ssq + (size_t)row * 8), sb = *(const f32x4*)(ssq + (size_t)row * 8 + 4);
                const float rstd = rsqrtf((((sa[0] + sa[1]) + (sa[2] + sa[3])) + ((sb[0] + sb[1]) + (sb[2] + sb[3]))) * (1.f / 256.f) + EPS) * qs;
                const int b = tok_b(row);
#pragma unroll
                for (int bj = 0; bj < 2; ++bj)
#pragma unroll
                    for (int n = 0; n < 2; ++n) {
                        const int col = EPI_COLBASE(u, bj) + n * 16 + 4 * fq, h = col / 96, dd = col - h * 96;
                        f32x4 v = acc[ai][bj][m][n];
                        if (dd >= 64 && row < NLAT) rope4(v, rope + ((size_t)(row & 8191) * 16 + ((dd - 64) >> 1)) * 2);
                        v = v * rstd;
                        u16* dst = row < NLAT ? Q + ((size_t)(b * 8 + h) * SEQ + (row & 8191)) * 96 + dd
                                              : Q + (size_t)NLAT * 768 + ((size_t)(b * 8 + h) * CTXL + ((row - NLAT) & 255)) * 96 + dd;
                        *(u32x2*)dst = pack4(v);
                    }
            }
    }
};

struct EpiKV {
    u16* KC; u16* VT; const float* sskv;
    DI void operator()(const AccT& acc, const Unit& u, int wr, int wc, int fr, int fq) const {
#pragma unroll
        for (int ai = 0; ai < 2; ++ai)
#pragma unroll
            for (int m = 0; m < 4; ++m) {
                const int row = EPI_ROW(u, ai, m);
                const f32x4 sa = *(const f32x4*)(sskv + (size_t)row * 4);
                const float rstd = rsqrtf(((sa[0] + sa[1]) + (sa[2] + sa[3])) * (1.f / 128.f) + EPS);
                const int b = tok_b(row);
                const int pos = row < NLAT ? 256 + (row & 8191) : ((row - NLAT) & 255);
#pragma unroll
                for (int bj = 0; bj < 2; ++bj)
#pragma unroll
                    for (int n = 0; n < 2; ++n) {
                        const int col = EPI_COLBASE(u, bj) + n * 16 + 4 * fq, h = col >> 7, c2 = col & 127;
                        const f32x4 v = acc[ai][bj][m][n] * rstd;
                        if (c2 < 64) *(u32x2*)(KC + ((size_t)(b * 8 + h) * LK + pos) * 96 + c2) = pack4(v);
                        else {
#pragma unroll
                            for (int j = 0; j < 4; ++j) VT[((size_t)(b * 8 + h) * 64 + (c2 - 64 + j)) * LK + pos] = f2bf(v[j]);
                        }
                    }
            }
    }
};

struct EpiGlu {
    const u16* Z; u16* HB;
    DI void operator()(const AccT& acc, const Unit& u, int wr, int wc, int fr, int fq) const {
#pragma unroll
        for (int ai = 0; ai < 2; ++ai)
#pragma unroll
            for (int m = 0; m < 4; ++m) {
                const int row = EPI_ROW(u, ai, m);
#pragma unroll
                for (int bj = 0; bj < 2; ++bj)
#pragma unroll
                    for (int n = 0; n < 2; ++n) {
                        const int col = EPI_COLBASE(u, bj) + n * 16 + 4 * fq;
                        const u32x2 z = *(const u32x2*)(Z + (size_t)row * 512 + col);
                        const f32x4 a = acc[ai][bj][m][n];
                        f32x4 o; o[0] = bflo(z.x) * sigmoidf_(a[0]); o[1] = bfhi(z.x) * sigmoidf_(a[1]); o[2] = bflo(z.y) * sigmoidf_(a[2]); o[3] = bfhi(z.y) * sigmoidf_(a[3]);
                        *(u32x2*)(HB + (size_t)row * 1024 + col) = pack4(o);
                    }
            }
    }
};

struct EpiRes {
    const float* srcLat; const float* srcCtx; const float* gate  ; float* X; float* part;
    DI void operator()(const AccT& acc, const Unit& u, int wr, int wc, int fr, int fq) const {
#pragma unroll
        for (int ai = 0; ai < 2; ++ai)
#pragma unroll
            for (int m = 0; m < 4; ++m) {
                const int row = EPI_ROW(u, ai, m);
                if (u.ks >= 0) {
                    float* pr = part + ((size_t)u.ks * NCTX + (row - NLAT)) * 1024;
#pragma unroll
                    for (int bj = 0; bj < 2; ++bj)
#pragma unroll
                        for (int n = 0; n < 2; ++n) *(f32x4*)(pr + EPI_COLBASE(u, bj) + n * 16 + 4 * fq) = acc[ai][bj][m][n];
                } else {
                    const float* src = row < NLAT ? srcLat + (size_t)row * 1024 : srcCtx + (size_t)(row - NLAT) * 1024;
                    const float* gv = gate + tok_bidx(row) * 6144;
#pragma unroll
                    for (int bj = 0; bj < 2; ++bj)
#pragma unroll
                        for (int n = 0; n < 2; ++n) {
                            const int col = EPI_COLBASE(u, bj) + n * 16 + 4 * fq;
                            const f32x4 s = *(const f32x4*)(src + col), gg = *(const f32x4*)(gv + col);
                            *(f32x4*)(X + (size_t)row * 1024 + col) = s + gg * acc[ai][bj][m][n];
                        }
                }
            }
    }
};

struct EpiFFN1 {
    u16* ACT;
    DI void operator()(const AccT& acc, const Unit& u, int wr, int wc, int fr, int fq) const {
#pragma unroll
        for (int ai = 0; ai < 2; ++ai)
#pragma unroll
            for (int m = 0; m < 4; ++m) {
                const int row = EPI_ROW(u, ai, m);
#pragma unroll
                for (int bj = 0; bj < 2; ++bj) {
                    const int col = (EPI_COLBASE(u, bj) >> 1) + 4 * fq;
                    const f32x4 g = acc[ai][bj][m][0], up = acc[ai][bj][m][1];
                    f32x4 o; o[0] = siluf_(g[0]) * up[0]; o[1] = siluf_(g[1]) * up[1]; o[2] = siluf_(g[2]) * up[2]; o[3] = siluf_(g[3]) * up[3];
                    *(u32x2*)(ACT + (size_t)row * DFF + col) = pack4(o);
                }
            }
    }
};

struct EpiInOdd {
    u16* PROJ; const float* rope;
    DI void operator()(const AccT& acc, const Unit& u, int wr, int wc, int fr, int fq) const {
#pragma unroll
        for (int ai = 0; ai < 2; ++ai)
#pragma unroll
            for (int m = 0; m < 4; ++m) {
                const int row = EPI_ROW(u, ai, m);
#pragma unroll
                for (int bj = 0; bj < 2; ++bj) {
                    const int cb = EPI_COLBASE(u, bj), seg = cb >> 9;
#pragma unroll
                    for (int n = 0; n < 2; ++n) {
                        const int col = cb + n * 16 + 4 * fq;
                        f32x4 v = acc[ai][bj][m][n];
                        if (seg < 2) {
                            if (row < NLAT) rope4(v, rope + ((size_t)(row & 8191) * 64 + ((col & 127) >> 1)) * 2);
                            if (seg == 1) v = v * 0.08838834764831845f;
                        }
                        *(u32x2*)(PROJ + (size_t)row * 4608 + col) = pack4(v);
                    }
                }
            }
    }
};

struct ConvJob { const float* src; u16* dst; const float* rowscale; int K, N, lds_, Npad, ldd, koff, inter; };
DI void conv_job(const ConvJob& J, float* tile) {
    const int tid = tidx(), ntn = J.Npad / 64, tiles = (J.K / 64) * ntn;
    for (int t = blockIdx.x; t < tiles; t += gridDim.x) {
        const int kt = t / ntn, nt = t - kt * ntn;
#pragma unroll
        for (int i = 0; i < 8; ++i) {
            const int kl = (tid >> 6) + 8 * i, nl = tid & 63, k = kt * 64 + kl, n = nt * 64 + nl;
            float v = 0.f;
            if (n < J.N) { v = J.src[(size_t)k * J.lds_ + n]; if (J.rowscale) v *= J.rowscale[k]; }
            tile[kl * 65 + nl] = v;
        }
        __syncthreads();
#pragma unroll
        for (int i = 0; i < 8; ++i) {
            const int nl = (tid >> 6) + 8 * i, kl = tid & 63, n = nt * 64 + nl;
            const int drow = J.inter ? (32 * (n >> 4) + (n & 15) + (J.inter == 2 ? 16 : 0)) : n;
            J.dst[(size_t)drow * J.ldd + J.koff + kt * 64 + kl] = f2bf(tile[kl * 65 + nl]);
        }
        __syncthreads();
    }
}
DI void conv_mixer_weights(const Params& p, int li, float* tile) {
    unsigned char* W = p.ws + OFF_WMIX;
    const int j = li >> 1;
    if ((li & 1) == 0) {
        ConvJob a{p.in[11] + (size_t)j * 1024 * 928, (u16*)(W + WE_IN), nullptr, 1024, 928, 928, 1024, 1024, 0, 0}; conv_job(a, tile);
        ConvJob b{p.in[12] + (size_t)j * 1024 * 1024, (u16*)(W + WE_OUT), nullptr, 1024, 1024, 1024, 1024, 1024, 0, 0}; conv_job(b, tile);
        ConvJob c{p.in[21] + (size_t)j * 512 * 512, (u16*)(W + WE_GLU), nullptr, 512, 512, 512, 512, 512, 0, 0}; conv_job(c, tile);
        ConvJob d{p.in[23] + (size_t)j * 256 * 768, (u16*)(W + WE_UQ), p.in[22] + j * 256, 256, 768, 768, 768, 256, 0, 0}; conv_job(d, tile);
        ConvJob e{p.in[25] + (size_t)j * 128 * 1024, (u16*)(W + WE_UKV), p.in[24] + j * 128, 128, 1024, 1024, 1024, 256, 128, 0}; conv_job(e, tile);
        u16* z = (u16*)(W + WE_UKV);
        for (int i = blockIdx.x * 512 + tidx(); i < 1024 * 128; i += gridDim.x * 512) z[(size_t)(i >> 7) * 256 + (i & 127)] = 0;
    } else {
        ConvJob a{p.in[26] + (size_t)j * 1024 * 4608, (u16*)(W + WO_IN), nullptr, 1024, 4608, 4608, 4608, 1024, 0, 0}; conv_job(a, tile);
        ConvJob b{p.in[27] + (size_t)j * 1024 * 1024, (u16*)(W + WO_OUT), nullptr, 1024, 1024, 1024, 1024, 1024, 0, 0}; conv_job(b, tile);
    }
}
DI void conv_ffn_weights(const Params& p, int li, float* tile) {
    unsigned char* W = p.ws + OFF_WFFN;
    ConvJob a{p.in[8] + (size_t)li * 1024 * DFF, (u16*)(W + WF_13), nullptr, 1024, DFF, DFF, DFF, 1024, 0, 1}; conv_job(a, tile);
    ConvJob b{p.in[9] + (size_t)li * 1024 * DFF, (u16*)(W + WF_13), nullptr, 1024, DFF, DFF, DFF, 1024, 0, 2}; conv_job(b, tile);
    ConvJob c{p.in[10] + (size_t)li * DFF * 1024, (u16*)(W + WF_2), nullptr, DFF, 1024, 1024, 1024, DFF, 0, 0}; conv_job(c, tile);
}

DI void norm_rows(const float* srcLat, const float* srcCtx, const float* g, const float* modl, int aoff, int soff, u16* H,
                  const float* part, int KS, const float* gctx, float* xw) {
    const int wid = tidx() >> 6, lane = tidx() & 63;
    for (int row = blockIdx.x * 8 + wid; row < NTOK; row += gridDim.x * 8) {
        const float* src = row < NLAT ? srcLat + (size_t)row * 1024 : srcCtx + (size_t)(row - NLAT) * 1024;
        const float* mv = modl + tok_bidx(row) * 6144;
        f32x4 v[4]; float ss = 0.f;
#pragma unroll
        for (int i = 0; i < 4; ++i) v[i] = *(const f32x4*)(src + i * 256 + lane * 4);
        if (part != nullptr && row >= NLAT) {
#pragma unroll
            for (int i = 0; i < 4; ++i) { const int col = i * 256 + lane * 4; f32x4 a = (f32x4){0.f, 0.f, 0.f, 0.f};
                for (int k = 0; k < KS; ++k) a += *(const f32x4*)(part + ((size_t)k * NCTX + (row - NLAT)) * 1024 + col);
                v[i] += *(const f32x4*)(gctx + col) * a;
                *(f32x4*)(xw + (size_t)row * 1024 + col) = v[i]; }
        }
#pragma unroll
        for (int i = 0; i < 4; ++i) ss += v[i][0] * v[i][0] + v[i][1] * v[i][1] + v[i][2] * v[i][2] + v[i][3] * v[i][3];
#pragma unroll
        for (int o = 1; o < 64; o <<= 1) ss += __shfl_xor(ss, o);
        const float rstd = rsqrtf(ss * (1.f / 1024.f) + EPS);
#pragma unroll
        for (int i = 0; i < 4; ++i) {
            const int col = i * 256 + lane * 4;
            const f32x4 gg = *(const f32x4*)(g + col), a = *(const f32x4*)(mv + aoff + col), s = *(const f32x4*)(mv + soff + col);
            const f32x4 h = v[i] * rstd * gg * (a + 1.f) + s;
            *(u32x2*)(H + (size_t)row * 1024 + col) = pack4(h);
        }
    }
}
DI void final_norm_rows(const float* X, const float* g, float* out) {
    const int wid = tidx() >> 6, lane = tidx() & 63;
    for (int row = blockIdx.x * 8 + wid; row < NLAT; row += gridDim.x * 8) {
        const float* src = X + (size_t)row * 1024;
        f32x4 v[4]; float ss = 0.f;
#pragma unroll
        for (int i = 0; i < 4; ++i) { v[i] = *(const f32x4*)(src + i * 256 + lane * 4); ss += v[i][0] * v[i][0] + v[i][1] * v[i][1] + v[i][2] * v[i][2] + v[i][3] * v[i][3]; }
#pragma unroll
        for (int o = 1; o < 64; o <<= 1) ss += __shfl_xor(ss, o);
        const float rstd = rsqrtf(ss * (1.f / 1024.f) + EPS);
#pragma unroll
        for (int i = 0; i < 4; ++i) { const int col = i * 256 + lane * 4; *(f32x4*)(out + (size_t)row * 1024 + col) = v[i] * rstd * *(const f32x4*)(g + col); }
    }
}

DI void prep_phase(const Params& p, float* ldsf) {
    const int tid = tidx(), gt = blockIdx.x * 512 + tid, gs = gridDim.x * 512;
    float* mod = (float*)(p.ws + OFF_MOD);
    {
        for (int i = tid; i < 3072; i += 512) { const int v = i >> 10, k = i & 1023; const float x = v < 2 ? p.in[1][v * 1024 + k] : p.in[3][k]; ldsf[i] = siluf_(x); }
        __syncthreads();
        for (int u = blockIdx.x; u < 4 * 12 * 16; u += gridDim.x) {
            const int ks = u & 15, cbk = (u >> 4) % 12, li = u / 192, n = cbk * 512 + tid, k0 = ks * 64;
            const float* w = p.in[4] + ((size_t)li * 1024 + k0) * 6144 + n;
            float a0 = 0.f, a1 = 0.f, a2 = 0.f;
#pragma unroll 16
            for (int k = 0; k < 64; ++k) { const float wv = w[(size_t)k * 6144]; a0 += ldsf[k0 + k] * wv; a1 += ldsf[1024 + k0 + k] * wv; a2 += ldsf[2048 + k0 + k] * wv; }
            if (ks == 0) { const float bm = p.in[5][li * 6144 + n]; a0 += bm; a1 += bm; a2 += bm; }
            float* mp = (float*)(p.ws + OFF_MODP) + (size_t)ks * (4 * 3 * 6144);
            mp[(li * 3 + 0) * 6144 + n] = a0; mp[(li * 3 + 1) * 6144 + n] = a1; mp[(li * 3 + 2) * 6144 + n] = a2;
        }
        __syncthreads();
    }
    float* rm = (float*)(p.ws + OFF_RMLA); float* rr = (float*)(p.ws + OFF_RRET);
    for (int i = gt; i < 8192 * 16; i += gs) { const int l = i >> 4, q = i & 15, r = l >> 6, c = l & 63;
        const float inv = powf(10000.f, -(float)(q & 7) / 8.f); const float ang = (float)(q < 8 ? r : c) * inv;
        float sn, cs; sincosf(ang, &sn, &cs); rm[2 * i] = cs; rm[2 * i + 1] = sn; }
    for (int i = gt; i < 8192 * 64; i += gs) { const int l = i >> 6, q = i & 63, r = l >> 6, c = l & 63;
        const float inv = powf(10000.f, -(float)(q & 31) / 32.f); const float ang = (float)(q < 32 ? r : c) * inv;
        float sn, cs; sincosf(ang, &sn, &cs); rr[2 * i] = cs; rr[2 * i + 1] = sn; }
    float* lb = (float*)(p.ws + OFF_LB);
    for (int i = gt; i < 512; i += gs) { const float a = p.in[29][i], b = p.in[29][512 + i], c = p.in[29][1024 + i]; const float mx = fmaxf(a, fmaxf(b, c));
        const float ea = expf(a - mx), eb = expf(b - mx), ec = expf(c - mx), s = ea + eb + ec; lb[i] = ea / s; lb[512 + i] = (ea + eb) / s; }
    float2* sab = (float2*)(p.ws + OFF_SAB); float2* sa64 = (float2*)(p.ws + OFF_SA64); float2* sbb = (float2*)(p.ws + OFF_SBB); u16* scc = (u16*)(p.ws + OFF_SCC);
    for (int i = gt; i < 2 * 2 * 2048; i += gs) {
        const int gp = i & 2047, jr = i >> 11, g = gp >> 6, pp = gp & 63;
        const double are = p.in[13][i], aim = p.in[14][i], dt = exp((double)p.in[15][jr * 32 + g]);
        const double mag = exp(are * dt), abr = mag * cos(aim * dt), abi = mag * sin(aim * dt);
        sab[i] = make_float2((float)abr, (float)abi);
        const double m64 = exp(are * dt * 64.0); sa64[i] = make_float2((float)(m64 * cos(aim * dt * 64.0)), (float)(m64 * sin(aim * dt * 64.0)));
        const double nr = abr - 1.0, ni = abi, den = are * are + aim * aim;
        const double fr = (nr * are + ni * aim) / den, fi = (ni * are - nr * aim) / den;
        { u16* sbbt = (u16*)sbb;
          for (int k = 0; k < 16; ++k) { const double br = p.in[16][(size_t)i * 16 + k], bi = p.in[17][(size_t)i * 16 + k];
            sbbt[((size_t)(jr * 32 + g) * 128 + pp) * 16 + k] = f2bf((float)(fr * br - fi * bi));
            sbbt[((size_t)(jr * 32 + g) * 128 + 64 + pp) * 16 + k] = f2bf((float)(fr * bi + fi * br)); } }
        for (int k = 0; k < 16; ++k) { const size_t ci = ((size_t)(jr * 32 + g) * 16 + k) * 64 + pp;
            scc[((size_t)(jr * 32 + g) * 16 + k) * 128 + pp] = f2bf(p.in[18][ci]); scc[((size_t)(jr * 32 + g) * 16 + k) * 128 + 64 + pp] = f2bf(-p.in[19][ci]); }
    }
    conv_mixer_weights(p, 0, ldsf);
}

constexpr int AT_KROW = 208, AT_VROW = 144, AT_KBUF = 64 * AT_KROW, AT_VBUF = 64 * AT_VROW, AT_BUF = AT_KBUF + AT_VBUF;
DI void attn_unit(LAS unsigned char* lds, const u16* Qp, const u16* Kp, const u16* Vp, int nkt, u16* outp) {
    const int tid = tidx(), wid = tid >> 6, lane = tid & 63, l31 = lane & 31, hh = lane >> 5;
    bf16x8 qf[6];
    { const u16* qr = Qp + (size_t)(wid * 32 + l31) * 96 + 8 * hh;
#pragma unroll
      for (int s = 0; s < 6; ++s) qf[s] = *(const bf16x8*)(qr + 16 * s); }
    f32x16 o0, o1;
#pragma unroll
    for (int i = 0; i < 16; ++i) { o0[i] = 0.f; o1[i] = 0.f; }
    float m_run = -1e30f, lsum = 0.f;
    const int kr0 = tid / 12, kp0 = tid - kr0 * 12, c1 = 512 + tid, kr1 = c1 / 12, kp1 = c1 - kr1 * 12, vr = tid >> 3, vp = tid & 7;
    u32x4 rk0, rk1 = (u32x4){0u, 0u, 0u, 0u}, rv;
    rk0 = *(const u32x4*)(Kp + (size_t)kr0 * 96 + kp0 * 8);
    if (tid < 256) rk1 = *(const u32x4*)(Kp + (size_t)kr1 * 96 + kp1 * 8);
    rv = *(const u32x4*)(Vp + (size_t)vr * LK + vp * 8);
    *(LAS u32x4*)(lds + kr0 * AT_KROW + kp0 * 16) = rk0;
    if (tid < 256) *(LAS u32x4*)(lds + kr1 * AT_KROW + kp1 * 16) = rk1;
    *(LAS u32x4*)(lds + AT_KBUF + vr * AT_VROW + vp * 16) = rv;
    __syncthreads();
    for (int kt = 0; kt < nkt; ++kt) {
        LAS unsigned char* kb_ = lds + (kt & 1) * AT_BUF; LAS unsigned char* vb_ = kb_ + AT_KBUF;
        const bool more = kt + 1 < nkt;
        if (more) { const u16* kn = Kp + (size_t)(kt + 1) * 64 * 96; const u16* vn = Vp + (size_t)(kt + 1) * 64;
            rk0 = *(const u32x4*)(kn + (size_t)kr0 * 96 + kp0 * 8);
            if (tid < 256) rk1 = *(const u32x4*)(kn + (size_t)kr1 * 96 + kp1 * 8);
            rv = *(const u32x4*)(vn + (size_t)vr * LK + vp * 8); }
        f32x16 st0, st1;
#pragma unroll
        for (int i = 0; i < 16; ++i) { st0[i] = 0.f; st1[i] = 0.f; }
#pragma unroll
        for (int s = 0; s < 6; ++s) {
            const bf16x8 a0 = *(const LAS bf16x8*)(kb_ + l31 * AT_KROW + (16 * s + 8 * hh) * 2);
            const bf16x8 a1 = *(const LAS bf16x8*)(kb_ + (32 + l31) * AT_KROW + (16 * s + 8 * hh) * 2);
            st0 = MFMA32(a0, qf[s], st0); st1 = MFMA32(a1, qf[s], st1);
        }
        float mx = st0[0];
#pragma unroll
        for (int i = 0; i < 16; ++i) { mx = fmaxf(mx, st0[i]); mx = fmaxf(mx, st1[i]); }
        { const auto sw_ = __builtin_amdgcn_permlane32_swap(__float_as_uint(mx), __float_as_uint(mx), false, false);
          mx = fmaxf(__uint_as_float(sw_[0]), __uint_as_float(sw_[1])); }
        if (__builtin_amdgcn_ballot_w64(mx > m_run + 8.0f) != 0ull) {
            const float m_new = fmaxf(m_run, mx), alpha = __builtin_amdgcn_exp2f(m_run - m_new);
            m_run = m_new; lsum *= alpha;
#pragma unroll
            for (int i = 0; i < 16; ++i) { o0[i] *= alpha; o1[i] *= alpha; } }
        float ps = 0.f;
#pragma unroll
        for (int i = 0; i < 16; ++i) { st0[i] = __builtin_amdgcn_exp2f(st0[i] - m_run); st1[i] = __builtin_amdgcn_exp2f(st1[i] - m_run); ps += st0[i] + st1[i]; }
        lsum += ps;
#pragma unroll
        for (int kb = 0; kb < 2; ++kb)
#pragma unroll
            for (int s = 0; s < 2; ++s) {
                u32x4 pw;
                if (kb == 0) { pw.x = pk2(st0[8 * s], st0[8 * s + 1]); pw.y = pk2(st0[8 * s + 2], st0[8 * s + 3]); pw.z = pk2(st0[8 * s + 4], st0[8 * s + 5]); pw.w = pk2(st0[8 * s + 6], st0[8 * s + 7]); }
                else         { pw.x = pk2(st1[8 * s], st1[8 * s + 1]); pw.y = pk2(st1[8 * s + 2], st1[8 * s + 3]); pw.z = pk2(st1[8 * s + 4], st1[8 * s + 5]); pw.w = pk2(st1[8 * s + 6], st1[8 * s + 7]); }
                const bf16x8 pb = __builtin_bit_cast(bf16x8, pw);
                const int koff = (32 * kb + 16 * s + 4 * hh) * 2;
                { const u32x2 lo = *(const LAS u32x2*)(vb_ + l31 * AT_VROW + koff), hi = *(const LAS u32x2*)(vb_ + l31 * AT_VROW + koff + 16);
                  u32x4 va; va.x = lo.x; va.y = lo.y; va.z = hi.x; va.w = hi.y; o0 = MFMA32(__builtin_bit_cast(bf16x8, va), pb, o0); }
                { const u32x2 lo = *(const LAS u32x2*)(vb_ + (32 + l31) * AT_VROW + koff), hi = *(const LAS u32x2*)(vb_ + (32 + l31) * AT_VROW + koff + 16);
                  u32x4 va; va.x = lo.x; va.y = lo.y; va.z = hi.x; va.w = hi.y; o1 = MFMA32(__builtin_bit_cast(bf16x8, va), pb, o1); }
            }
        if (more) { LAS unsigned char* nb = lds + ((kt + 1) & 1) * AT_BUF;
            *(LAS u32x4*)(nb + kr0 * AT_KROW + kp0 * 16) = rk0;
            if (tid < 256) *(LAS u32x4*)(nb + kr1 * AT_KROW + kp1 * 16) = rk1;
            *(LAS u32x4*)(nb + AT_KBUF + vr * AT_VROW + vp * 16) = rv; }
        __syncthreads();
    }
    const float lt = lsum + __shfl_xor(lsum, 32), inv = 1.f / lt;
    u16* orow = outp + (size_t)(wid * 32 + l31) * 1024;
#pragma unroll
    for (int g = 0; g < 4; ++g) {
        u32x2 w0, w1;
        w0.x = pk2(o0[4 * g] * inv, o0[4 * g + 1] * inv); w0.y = pk2(o0[4 * g + 2] * inv, o0[4 * g + 3] * inv);
        w1.x = pk2(o1[4 * g] * inv, o1[4 * g + 1] * inv); w1.y = pk2(o1[4 * g + 2] * inv, o1[4 * g + 3] * inv);
        *(u32x2*)(orow + 8 * g + 4 * hh) = w0; *(u32x2*)(orow + 32 + 8 * g + 4 * hh) = w1;
    }
}


DI void attn_unit64(LAS unsigned char* lds, const u16* Qp, const u16* Kp, const u16* Vp, int nkt, u16* outp) {
    const int tid = tidx(), wid = tid >> 6, lane = tid & 63, l31 = lane & 31, hh = lane >> 5;
    bf16x8 qf0[6], qf1[6];
    { const u16* qr = Qp + (size_t)(wid * 64 + l31) * 96 + 8 * hh;
#pragma unroll
      for (int s = 0; s < 6; ++s) { qf0[s] = *(const bf16x8*)(qr + 16 * s); qf1[s] = *(const bf16x8*)(qr + 32 * 96 + 16 * s); } }
    f32x16 oa0, oa1, ob0, ob1;
#pragma unroll
    for (int i = 0; i < 16; ++i) { oa0[i] = 0.f; oa1[i] = 0.f; ob0[i] = 0.f; ob1[i] = 0.f; }
    float ma = -1e30f, mb = -1e30f, la = 0.f, lb = 0.f;
    const int kr0 = tid / 12, kp0 = tid - kr0 * 12, c1 = 512 + tid, kr1 = c1 / 12, kp1 = c1 - kr1 * 12, vr = tid >> 3, vp = tid & 7;
    u32x4 rk0, rk1 = (u32x4){0u, 0u, 0u, 0u}, rv;
    rk0 = *(const u32x4*)(Kp + (size_t)kr0 * 96 + kp0 * 8);
    if (tid < 256) rk1 = *(const u32x4*)(Kp + (size_t)kr1 * 96 + kp1 * 8);
    rv = *(const u32x4*)(Vp + (size_t)vr * LK + vp * 8);
    *(LAS u32x4*)(lds + kr0 * AT_KROW + kp0 * 16) = rk0;
    if (tid < 256) *(LAS u32x4*)(lds + kr1 * AT_KROW + kp1 * 16) = rk1;
    *(LAS u32x4*)(lds + AT_KBUF + vr * AT_VROW + vp * 16) = rv;
    __syncthreads();
    for (int kt = 0; kt < nkt; ++kt) {
        LAS unsigned char* kb_ = lds + (kt & 1) * AT_BUF; LAS unsigned char* vb_ = kb_ + AT_KBUF;
        const bool more = kt + 1 < nkt;
        if (more) { const u16* kn = Kp + (size_t)(kt + 1) * 64 * 96; const u16* vn = Vp + (size_t)(kt + 1) * 64;
            rk0 = *(const u32x4*)(kn + (size_t)kr0 * 96 + kp0 * 8);
            if (tid < 256) rk1 = *(const u32x4*)(kn + (size_t)kr1 * 96 + kp1 * 8);
            rv = *(const u32x4*)(vn + (size_t)vr * LK + vp * 8); }
        f32x16 sa0, sa1, sb0, sb1;
#pragma unroll
        for (int i = 0; i < 16; ++i) { sa0[i] = 0.f; sa1[i] = 0.f; sb0[i] = 0.f; sb1[i] = 0.f; }
#pragma unroll
        for (int s = 0; s < 6; ++s) {
            const bf16x8 a0 = *(const LAS bf16x8*)(kb_ + l31 * AT_KROW + (16 * s + 8 * hh) * 2);
            const bf16x8 a1 = *(const LAS bf16x8*)(kb_ + (32 + l31) * AT_KROW + (16 * s + 8 * hh) * 2);
            sa0 = MFMA32(a0, qf0[s], sa0); sa1 = MFMA32(a1, qf0[s], sa1);
            sb0 = MFMA32(a0, qf1[s], sb0); sb1 = MFMA32(a1, qf1[s], sb1);
        }
        u32x4 pa[4], pb[4];
#define AT_SOFTMAX(S0, S1, M, L, O0, O1, P) do { \
        float mx = S0[0]; \
        _Pragma("unroll") for (int i = 0; i < 16; ++i) { mx = fmaxf(mx, S0[i]); mx = fmaxf(mx, S1[i]); } \
        { const auto sw_ = __builtin_amdgcn_permlane32_swap(__float_as_uint(mx), __float_as_uint(mx), false, false); \
          mx = fmaxf(__uint_as_float(sw_[0]), __uint_as_float(sw_[1])); }     \
        const float m_new = fmaxf(M, mx); \
        if (__builtin_amdgcn_ballot_w64(mx > M + 8.0f) != 0ull) {     const float alpha = __builtin_amdgcn_exp2f(M - m_new); M = m_new; L *= alpha; \
            _Pragma("unroll") for (int i = 0; i < 16; ++i) { O0[i] *= alpha; O1[i] *= alpha; } } \
        float ps = 0.f; \
        _Pragma("unroll") for (int i = 0; i < 16; ++i) { S0[i] = __builtin_amdgcn_exp2f(S0[i] - M); S1[i] = __builtin_amdgcn_exp2f(S1[i] - M); ps += S0[i] + S1[i]; } \
        L += ps; \
        _Pragma("unroll") for (int s = 0; s < 2; ++s) { \
            P[s].x = pk2(S0[8 * s], S0[8 * s + 1]); P[s].y = pk2(S0[8 * s + 2], S0[8 * s + 3]); P[s].z = pk2(S0[8 * s + 4], S0[8 * s + 5]); P[s].w = pk2(S0[8 * s + 6], S0[8 * s + 7]); \
            P[2 + s].x = pk2(S1[8 * s], S1[8 * s + 1]); P[2 + s].y = pk2(S1[8 * s + 2], S1[8 * s + 3]); P[2 + s].z = pk2(S1[8 * s + 4], S1[8 * s + 5]); P[2 + s].w = pk2(S1[8 * s + 6], S1[8 * s + 7]); } \
        } while (0)
        AT_SOFTMAX(sa0, sa1, ma, la, oa0, oa1, pa);
        AT_SOFTMAX(sb0, sb1, mb, lb, ob0, ob1, pb);
#undef AT_SOFTMAX
#pragma unroll
        for (int kb = 0; kb < 2; ++kb)
#pragma unroll
            for (int s = 0; s < 2; ++s) {
                const int koff = (32 * kb + 16 * s + 4 * hh) * 2;
                const u32x2 lo0 = *(const LAS u32x2*)(vb_ + l31 * AT_VROW + koff), hi0 = *(const LAS u32x2*)(vb_ + l31 * AT_VROW + koff + 16);
                const u32x2 lo1 = *(const LAS u32x2*)(vb_ + (32 + l31) * AT_VROW + koff), hi1 = *(const LAS u32x2*)(vb_ + (32 + l31) * AT_VROW + koff + 16);
                u32x4 va0, va1; va0.x = lo0.x; va0.y = lo0.y; va0.z = hi0.x; va0.w = hi0.y; va1.x = lo1.x; va1.y = lo1.y; va1.z = hi1.x; va1.w = hi1.y;
                const bf16x8 v0 = __builtin_bit_cast(bf16x8, va0), v1 = __builtin_bit_cast(bf16x8, va1);
                const bf16x8 pA = __builtin_bit_cast(bf16x8, pa[kb * 2 + s]), pB = __builtin_bit_cast(bf16x8, pb[kb * 2 + s]);
                oa0 = MFMA32(v0, pA, oa0); oa1 = MFMA32(v1, pA, oa1);
                ob0 = MFMA32(v0, pB, ob0); ob1 = MFMA32(v1, pB, ob1);
            }
        if (more) { LAS unsigned char* nb = lds + ((kt + 1) & 1) * AT_BUF;
            *(LAS u32x4*)(nb + kr0 * AT_KROW + kp0 * 16) = rk0;
            if (tid < 256) *(LAS u32x4*)(nb + kr1 * AT_KROW + kp1 * 16) = rk1;
            *(LAS u32x4*)(nb + AT_KBUF + vr * AT_VROW + vp * 16) = rv; }
        __syncthreads();
    }
    {   const float lt = la + __shfl_xor(la, 32), inv = 1.f / lt;
        u16* orow = outp + (size_t)(wid * 64 + l31) * 1024;
#pragma unroll
        for (int g = 0; g < 4; ++g) { u32x2 w0, w1;
            w0.x = pk2(oa0[4 * g] * inv, oa0[4 * g + 1] * inv); w0.y = pk2(oa0[4 * g + 2] * inv, oa0[4 * g + 3] * inv);
            w1.x = pk2(oa1[4 * g] * inv, oa1[4 * g + 1] * inv); w1.y = pk2(oa1[4 * g + 2] * inv, oa1[4 * g + 3] * inv);
            *(u32x2*)(orow + 8 * g + 4 * hh) = w0; *(u32x2*)(orow + 32 + 8 * g + 4 * hh) = w1; } }
    {   const float lt = lb + __shfl_xor(lb, 32), inv = 1.f / lt;
        u16* orow = outp + (size_t)(wid * 64 + 32 + l31) * 1024;
#pragma unroll
        for (int g = 0; g < 4; ++g) { u32x2 w0, w1;
            w0.x = pk2(ob0[4 * g] * inv, ob0[4 * g + 1] * inv); w0.y = pk2(ob0[4 * g + 2] * inv, ob0[4 * g + 3] * inv);
            w1.x = pk2(ob1[4 * g] * inv, ob1[4 * g + 1] * inv); w1.y = pk2(ob1[4 * g + 2] * inv, ob1[4 * g + 3] * inv);
            *(u32x2*)(orow + 8 * g + 4 * hh) = w0; *(u32x2*)(orow + 32 + 8 * g + 4 * hh) = w1; } }
}

DI int s5_rowbase(int b, int jc) { return jc < 4 ? NLAT + b * 256 + jc * 64 : b * 8192 + (jc - 4) * 64; }
constexpr int S5_BU = 16 * 132 * 4, S5_HB = 16 * 136 * 2, S5_WAVE = S5_BU + S5_HB;
#define S5_WAVE_SYNC() do { asm volatile("s_waitcnt vmcnt(0) lgkmcnt(0)" ::: "memory"); __builtin_amdgcn_wave_barrier(); } while (0)
template <bool WITH_C>
DI void s5_dir(const Params& p, int j, int dir, int g, int rowbase, float& hr, float& hi, f32x4 (&acc)[4], unsigned char* lw) {
    const int lane = tidx() & 63, lq = lane >> 4, l15 = lane & 15, gp = g * 64 + lane;
    const int tdir = (j * 2 + dir);
    const float2 A = ((const float2*)(p.ws + OFF_SAB))[tdir * 2048 + gp];
    const u16* U = (const u16*)(p.ws + OFF_BIG + BE_U);
    const u16* sbbt = (const u16*)(p.ws + OFF_SBB) + (size_t)(tdir * 32 + g) * 128 * 16;
    const bf16x8 zero8 = (bf16x8){0, 0, 0, 0, 0, 0, 0, 0};
    bf16x8 bfr[8];
#pragma unroll
    for (int nt = 0; nt < 8; ++nt) bfr[nt] = lq < 2 ? *(const bf16x8*)(sbbt + (16 * nt + l15) * 16 + 8 * lq) : zero8;
    bf16x8 cf[4];
    if (WITH_C) { const u16* cp = (const u16*)(p.ws + OFF_SCC) + ((size_t)(tdir * 32 + g) * 16 + l15) * 128 + 8 * lq;
#pragma unroll
        for (int s = 0; s < 4; ++s) cf[s] = *(const bf16x8*)(cp + 32 * s); }
    bf16x8 ua[4];
#pragma unroll
    for (int sb = 0; sb < 4; ++sb) ua[sb] = lq < 2 ? *(const bf16x8*)(U + (size_t)(rowbase + 16 * sb + l15) * 512 + g * 16 + 8 * lq) : zero8;
    float* bu = (float*)lw; u16* hb = (u16*)(lw + S5_BU);
#pragma unroll
    for (int sbi = 0; sbi < 4; ++sbi) {
        const int sb = dir ? 3 - sbi : sbi;
#pragma unroll
        for (int nt = 0; nt < 8; ++nt) {
            const f32x4 c = MFMA16(ua[sb], bfr[nt], ((f32x4){0.f, 0.f, 0.f, 0.f}));
#pragma unroll
            for (int i = 0; i < 4; ++i) bu[(4 * lq + i) * 132 + 16 * nt + l15] = c[i];
        }
        S5_WAVE_SYNC();
        for (int tt = 0; tt < 16; ++tt) {
            const int tl = dir ? 15 - tt : tt;
            const float br = bu[tl * 132 + lane], bi = bu[tl * 132 + 64 + lane];
            const float nr = A.x * hr - A.y * hi + br, ni = A.x * hi + A.y * hr + bi; hr = nr; hi = ni;
            if (WITH_C) { hb[tl * 136 + lane] = f2bf(hr); hb[tl * 136 + 64 + lane] = f2bf(hi); }
        }
        S5_WAVE_SYNC();
        if (WITH_C) {
            f32x4 a = (f32x4){0.f, 0.f, 0.f, 0.f};
#pragma unroll
            for (int s = 0; s < 4; ++s) { const bf16x8 af = *(const bf16x8*)(hb + l15 * 136 + 32 * s + 8 * lq); a = MFMA16(af, cf[s], a); }
            acc[sb] += a;
        }
    }
}
DI void s5_pass1_unit(const Params& p, int j, int unit, unsigned char* l) {
    const int gb = unit & 3, jc = (unit >> 2) % NCH, b = (unit >> 2) / NCH;
    const int tid = tidx(), w = tid >> 6, lane = tid & 63, g = gb * 8 + w, gp = g * 64 + lane;
    float2* E = (float2*)(p.ws + OFF_BIG + BE_S5E);
    const int rowbase = s5_rowbase(b, jc);
    f32x4 acc[4];
    __syncthreads();
#pragma unroll
    for (int dir = 0; dir < 2; ++dir) {
        float hr = 0.f, hi = 0.f;
        s5_dir<false>(p, j, dir, g, rowbase, hr, hi, acc, l + w * S5_WAVE);
        E[((size_t)(b * 2 + dir) * NCH + scan_idx(jc, dir)) * 2048 + gp] = make_float2(hr, hi);
    }
}
DI void s5_carry_scan(const Params& p, int j, int wg0) {
    const int nw = (int)gridDim.x - wg0;
    if ((int)blockIdx.x < wg0) return;
    for (int gt = ((int)blockIdx.x - wg0) * 512 + tidx(); gt < 8192; gt += nw * 512) {
    const int gp = gt & 2047, bd = gt >> 11, dir = bd & 1;
    float2* Ep = (float2*)(p.ws + OFF_BIG + BE_S5E) + (size_t)bd * NCH * 2048 + gp;
    const float2 A64 = ((const float2*)(p.ws + OFF_SA64))[(j * 2 + dir) * 2048 + gp];
    float hr = 0.f, hi = 0.f; asm volatile("" : "+v"(hr), "+v"(hi));
    for (int n0 = 0; n0 < NCH; n0 += 12) {
        float2 e[12];
#pragma unroll
        for (int i = 0; i < 12; ++i) e[i] = Ep[(size_t)(n0 + i) * 2048];
#pragma unroll
        for (int i = 0; i < 12; ++i) { Ep[(size_t)(n0 + i) * 2048] = make_float2(hr, hi);
            const float nr = A64.x * hr - A64.y * hi + e[i].x, ni = A64.x * hi + A64.y * hr + e[i].y; hr = nr; hi = ni; }
    }
    }
}
DI void s5_pass2_unit(const Params& p, int j, int unit, unsigned char* l) {
    const int gb = unit & 3, jc = (unit >> 2) % NCH, b = (unit >> 2) / NCH;
    const int tid = tidx(), w = tid >> 6, lane = tid & 63, g = gb * 8 + w, gp = g * 64 + lane;
    const u16* U = (const u16*)(p.ws + OFF_BIG + BE_U);
    const float2* E = (const float2*)(p.ws + OFF_BIG + BE_S5E);
    u16* Z = (u16*)(p.ws + OFF_BIG + BE_Z);
    const int rowbase = s5_rowbase(b, jc);
    f32x4 acc[4];
#pragma unroll
    for (int i = 0; i < 4; ++i) acc[i] = (f32x4){0.f, 0.f, 0.f, 0.f};
    __syncthreads();
#pragma unroll
    for (int dir = 0; dir < 2; ++dir) {
        const float2 h0 = E[((size_t)(b * 2 + dir) * NCH + scan_idx(jc, dir)) * 2048 + gp];
        float hr = h0.x, hi = h0.y;
        s5_dir<true>(p, j, dir, g, rowbase, hr, hi, acc, l + w * S5_WAVE);
    }
    const int col = g * 16 + (lane & 15);
    const float dcoef = p.in[20][j * 512 + col];
#pragma unroll
    for (int sb = 0; sb < 4; ++sb)
#pragma unroll
        for (int i = 0; i < 4; ++i) {
            const int t = sb * 16 + 4 * (lane >> 4) + i;
            const float y = acc[sb][i] + dcoef * bf2f(U[(size_t)(rowbase + t) * 512 + col]);
            Z[(size_t)(rowbase + t) * 512 + col] = f2bf(gelu_tanh(y));
        }
}

constexpr int GL_S136 = 136, GL_S72 = 72;
constexpr int GL_CUM = 0, GL_QT = 33792, GL_KT = GL_QT + 64 * 136 * 2, GL_QS = GL_KT + 64 * 136 * 2, GL_VT = GL_QS + 64 * 136 * 2, GL_ATT = GL_VT + 128 * 72 * 2, GL_KDT = GL_ATT + 64 * 72 * 2;
DI int gla_rowbase(int b, int jc) { return jc < 4 ? NLAT + b * 256 + jc * 64 : b * 8192 + (jc - 4) * 64; }
DI void ld16(const u16* p, float* f) {
    const u32x4 a = *(const u32x4*)p, b = *(const u32x4*)(p + 8);
    f[0] = bflo(a.x); f[1] = bfhi(a.x); f[2] = bflo(a.y); f[3] = bfhi(a.y); f[4] = bflo(a.z); f[5] = bfhi(a.z); f[6] = bflo(a.w); f[7] = bfhi(a.w);
    f[8] = bflo(b.x); f[9] = bfhi(b.x); f[10] = bflo(b.y); f[11] = bfhi(b.y); f[12] = bflo(b.z); f[13] = bfhi(b.z); f[14] = bflo(b.w); f[15] = bfhi(b.w);
}
DI void gla_cum(unsigned char* l, const u16* PROJ, const float* lbv, int mixer, int h, int dir, int rowbase, float* kv) {
    const int tid = tidx(), t = tid >> 3, d0 = (tid & 7) * 16;
    float* cum = (float*)(l + GL_CUM);
    const u16* prow = PROJ + (size_t)(rowbase + t) * 4608 + h * 128 + d0;
    if (mixer == 0) {
        const float lg = log1pf(-exp2f(-(5.f + 0.5f * dir) - (float)h));
        const float c = dir ? lg * (float)(64 - t) : lg * (float)(t + 1);
#pragma unroll
        for (int i = 0; i < 16; ++i) cum[t * 128 + d0 + i] = c;
        ld16(prow + 512, kv);
        __syncthreads();
    } else {
        float x[16]; ld16(prow + (dir ? 3072 : 2560), x);
#pragma unroll
        for (int i = 0; i < 16; ++i) { const float lbd = lbv[h * 128 + d0 + i]; const float f = lbd + (1.f - lbd) * sigmoidf_(x[i]); kv[i] = 1.f - f; cum[t * 128 + d0 + i] = __logf(f); }
        __syncthreads();
        { const int q = tid >> 7, d = tid & 127; float sacc = 0.f;
          if (dir == 0) { for (int r = 16 * q; r < 16 * q + 16; ++r) { sacc += cum[r * 128 + d]; cum[r * 128 + d] = sacc; } }
          else { for (int r = 16 * q + 15; r >= 16 * q; --r) { sacc += cum[r * 128 + d]; cum[r * 128 + d] = sacc; } }
          __syncthreads();
          float off = 0.f;
          if (dir == 0) { for (int qq = 0; qq < q; ++qq) off += cum[(16 * qq + 15) * 128 + d]; }
          else { for (int qq = q + 1; qq < 4; ++qq) off += cum[(16 * qq) * 128 + d]; }
          __syncthreads();
          for (int r = 16 * q; r < 16 * q + 16; ++r) cum[r * 128 + d] += off; }
        __syncthreads();
    }
}
DI void gla_load_vt(unsigned char* l, const u16* PROJ, int mixer, int h, int rowbase) {
    const int tid = tidx(), t = tid & 63, d0 = (tid >> 6) * 16;
    u16* vt = (u16*)(l + GL_VT);
    const u16* prow = PROJ + (size_t)(rowbase + t) * 4608 + (mixer ? 3584 : 1024) + h * 128 + d0;
    const u32x4 a = *(const u32x4*)prow, b = *(const u32x4*)(prow + 8);
    const unsigned wv[8] = {a.x, a.y, a.z, a.w, b.x, b.y, b.z, b.w};
#pragma unroll
    for (int i = 0; i < 8; ++i) { vt[(d0 + 2 * i) * GL_S72 + t] = (u16)(wv[i] & 0xffffu); vt[(d0 + 2 * i + 1) * GL_S72 + t] = (u16)(wv[i] >> 16); }
}
DI void gla_pass1_unit(const Params& p, int b, int lbj, int unit, unsigned char* l) {
    const int jc = unit % NCH, r0 = unit / NCH, dir = r0 & 1, h = (r0 >> 1) & 3, mixer = 1 - (r0 >> 3);
    const u16* PROJ = (const u16*)(p.ws + OFF_BIG + BO_PROJ);
    u16* GST = (u16*)(p.ws + OFF_BIG + BO_GST); float* GDEC = (float*)(p.ws + OFF_GDEC);
    const float* lbv = (const float*)(p.ws + OFF_LB) + lbj * 512;
    const int tid = tidx(), t = tid >> 3, d0 = (tid & 7) * 16, rowbase = gla_rowbase(b, jc);
    const int n = scan_idx(jc, dir);
    const size_t seq = (size_t)((mixer * 4 + h) * 2 + dir) * NCH + n;
    __syncthreads();
    float kv[16];
    gla_cum(l, PROJ, lbv, mixer, h, dir, rowbase, kv);
    gla_load_vt(l, PROJ, mixer, h, rowbase);
    const float* cum = (const float*)(l + GL_CUM); u16* kdt = (u16*)(l + GL_KDT);
    const int te = dir ? 0 : 63;
#pragma unroll
    for (int i = 0; i < 16; ++i) { const float e = cum[te * 128 + d0 + i]; kdt[(d0 + i) * GL_S72 + t] = f2bf(kv[i] * __expf(e - cum[t * 128 + d0 + i])); }
    if (tid < 128) GDEC[seq * 128 + tid] = __expf(cum[te * 128 + tid]);
    __syncthreads();
    const int w = tid >> 6, lane = tid & 63, l31 = lane & 31, hh = lane >> 5, er = w >> 1;
    const u16* vt = (const u16*)(l + GL_VT);
#pragma unroll
    for (int q = 0; q < 2; ++q) {
        const int dc = (w & 1) * 2 + q;
        f32x16 a;
#pragma unroll
        for (int i = 0; i < 16; ++i) a[i] = 0.f;
#pragma unroll
        for (int ks = 0; ks < 4; ++ks) {
            const bf16x8 af = *(const bf16x8*)(vt + (32 * er + l31) * GL_S72 + 16 * ks + 8 * hh);
            const bf16x8 bf = *(const bf16x8*)(kdt + (32 * dc + l31) * GL_S72 + 16 * ks + 8 * hh);
            a = MFMA32(af, bf, a);
        }
        u16* dst = GST + seq * 16384;
#pragma unroll
        for (int i = 0; i < 16; ++i) dst[(32 * er + crow32(i, hh)) * 128 + 32 * dc + l31] = f2bf(a[i]);
    }
}
DI void gla_scan(const Params& p) {
    u16* GST = (u16*)(p.ws + OFF_BIG + BO_GST); const float* GDEC = (const float*)(p.ws + OFF_GDEC);
    for (int gt = blockIdx.x * 512 + tidx(); gt < 16 * 8192; gt += gridDim.x * 512) {
    const int sq = gt >> 13, idx = (gt & 8191) * 2, d = idx & 127;
    unsigned* base = (unsigned*)(GST + (size_t)sq * NCH * 16384 + idx); const float* dec = GDEC + (size_t)sq * NCH * 128 + d;
    float s0 = 0.f, s1 = 0.f; asm volatile("" : "+v"(s0), "+v"(s1));
    for (int n0 = 0; n0 < NCH; n0 += 12) {
        unsigned kv[12]; float2 dc[12];
#pragma unroll
        for (int i = 0; i < 12; ++i) { kv[i] = base[(size_t)(n0 + i) * 8192]; dc[i] = *(const float2*)(dec + (size_t)(n0 + i) * 128); }
#pragma unroll
        for (int i = 0; i < 12; ++i) { base[(size_t)(n0 + i) * 8192] = pk2(s0, s1);
            s0 = dc[i].x * s0 + bflo(kv[i]); s1 = dc[i].y * s1 + bfhi(kv[i]); }
    }
    }
}
DI void gla_pass3_unit(const Params& p, int b, int lbj, int jodd, int unit, unsigned char* l, bool latent_only) {
    const int nch = latent_only ? 128 : NCH;
    const int jc = latent_only ? 4 + unit % 128 : unit % NCH, r0 = unit / nch, h = r0 & 3, mixer = 1 - (r0 >> 2);
    const u16* PROJ = (const u16*)(p.ws + OFF_BIG + BO_PROJ);
    const u16* GST = (const u16*)(p.ws + OFF_BIG + BO_GST);
    const float* lbv = (const float*)(p.ws + OFF_LB) + lbj * 512;
    u16* HB = (u16*)(p.ws + OFF_HB);
    const int tid = tidx(), t = tid >> 3, d0 = (tid & 7) * 16, rowbase = gla_rowbase(b, jc);
    const int w = tid >> 6, lane = tid & 63, l31 = lane & 31, hh = lane >> 5, tr = w >> 2, ec = w & 3;
    f32x16 oacc;
#pragma unroll
    for (int i = 0; i < 16; ++i) oacc[i] = 0.f;
    __syncthreads();
    gla_load_vt(l, PROJ, mixer, h, rowbase);
    float qv[16]; ld16(PROJ + (size_t)(rowbase + t) * 4608 + (mixer ? 2048 : 0) + h * 128 + d0, qv);
    for (int dir = 0; dir < 2; ++dir) {
        float kv[16];
        bf16x8 sfr[8];
        { const u16* S = GST + ((size_t)((mixer * 4 + h) * 2 + dir) * NCH + scan_idx(jc, dir)) * 16384 + (32 * ec + l31) * 128 + 8 * hh;
#pragma unroll
          for (int ks = 0; ks < 8; ++ks) sfr[ks] = *(const bf16x8*)(S + 16 * ks); }
        gla_cum(l, PROJ, lbv, mixer, h, dir, rowbase, kv);
        const float* cum = (const float*)(l + GL_CUM);
        u16* qt = (u16*)(l + GL_QT); u16* ktl = (u16*)(l + GL_KT); u16* qsl = (u16*)(l + GL_QS); u16* att = (u16*)(l + GL_ATT);
        const int tref = dir ? 32 : 31;
        {
            float fq_[16], fk_[16], fs_[16];
#pragma unroll
            for (int i = 0; i < 16; ++i) { const float c = cum[t * 128 + d0 + i], rf = cum[tref * 128 + d0 + i];
                fq_[i] = qv[i] * __expf(c - rf); fk_[i] = kv[i] * __expf(rf - c); fs_[i] = qv[i] * __expf(c); }
#pragma unroll
            for (int hf = 0; hf < 2; ++hf) { u32x4 wq, wk, ws;
                wq.x = pk2(fq_[8 * hf], fq_[8 * hf + 1]); wq.y = pk2(fq_[8 * hf + 2], fq_[8 * hf + 3]); wq.z = pk2(fq_[8 * hf + 4], fq_[8 * hf + 5]); wq.w = pk2(fq_[8 * hf + 6], fq_[8 * hf + 7]);
                wk.x = pk2(fk_[8 * hf], fk_[8 * hf + 1]); wk.y = pk2(fk_[8 * hf + 2], fk_[8 * hf + 3]); wk.z = pk2(fk_[8 * hf + 4], fk_[8 * hf + 5]); wk.w = pk2(fk_[8 * hf + 6], fk_[8 * hf + 7]);
                ws.x = pk2(fs_[8 * hf], fs_[8 * hf + 1]); ws.y = pk2(fs_[8 * hf + 2], fs_[8 * hf + 3]); ws.z = pk2(fs_[8 * hf + 4], fs_[8 * hf + 5]); ws.w = pk2(fs_[8 * hf + 6], fs_[8 * hf + 7]);
                *(u32x4*)(qt + t * GL_S136 + d0 + 8 * hf) = wq; *(u32x4*)(ktl + t * GL_S136 + d0 + 8 * hf) = wk; *(u32x4*)(qsl + t * GL_S136 + d0 + 8 * hf) = ws; }
        }
        __syncthreads();
        { const int tt = w >> 1;
#pragma unroll
          for (int q = 0; q < 2; ++q) { const int ts = (w & 1) * 2 + q;
            f32x4 a = (f32x4){0.f, 0.f, 0.f, 0.f};
#pragma unroll
            for (int ks = 0; ks < 4; ++ks) {
                const bf16x8 af = *(const bf16x8*)(qt + (16 * tt + (lane & 15)) * GL_S136 + 32 * ks + 8 * (lane >> 4));
                const bf16x8 bf = *(const bf16x8*)(ktl + (16 * ts + (lane & 15)) * GL_S136 + 32 * ks + 8 * (lane >> 4));
                a = MFMA16(af, bf, a); }
#pragma unroll
            for (int i = 0; i < 4; ++i) { const int trow = 16 * tt + 4 * (lane >> 4) + i, scol = 16 * ts + (lane & 15);
                const bool keep = dir ? (scol >= trow) : (scol <= trow);
                att[trow * GL_S72 + scol] = f2bf(keep ? a[i] : 0.f); } } }
        __syncthreads();
        const u16* vt = (const u16*)(l + GL_VT);
#pragma unroll
        for (int ks = 0; ks < 4; ++ks) {
            const bf16x8 af = *(const bf16x8*)(att + (32 * tr + l31) * GL_S72 + 16 * ks + 8 * hh);
            const bf16x8 bf = *(const bf16x8*)(vt + (32 * ec + l31) * GL_S72 + 16 * ks + 8 * hh);
            oacc = MFMA32(af, bf, oacc); }
#pragma unroll
        for (int ks = 0; ks < 8; ++ks) {
            const bf16x8 af = *(const bf16x8*)(qsl + (32 * tr + l31) * GL_S136 + 16 * ks + 8 * hh);
            oacc = MFMA32(af, sfr[ks], oacc); }
        __syncthreads();
    }
    float* ob = (float*)(l + GL_CUM);
#pragma unroll
    for (int i = 0; i < 16; ++i) ob[(32 * tr + crow32(i, hh)) * 132 + 32 * ec + l31] = oacc[i];
    __syncthreads();
    { float v[16]; float s = 0.f;
#pragma unroll
      for (int i = 0; i < 16; ++i) { v[i] = ob[t * 132 + d0 + i]; s += v[i]; }
      if (mixer == 0) { s += __shfl_xor(s, 1); s += __shfl_xor(s, 2); s += __shfl_xor(s, 4); const float mean = s * (1.f / 128.f);
#pragma unroll
          for (int i = 0; i < 16; ++i) v[i] -= mean; }
      float ss = 0.f;
#pragma unroll
      for (int i = 0; i < 16; ++i) ss += v[i] * v[i];
      ss += __shfl_xor(ss, 1); ss += __shfl_xor(ss, 2); ss += __shfl_xor(ss, 4);
      const float rstd = rsqrtf(ss * (1.f / 128.f) + EPS);
      const float* gn = (mixer ? p.in[30] : p.in[28]) + jodd * 512 + h * 128 + d0;
      float gt_[16]; ld16(PROJ + (size_t)(rowbase + t) * 4608 + (mixer ? 4096 : 1536) + h * 128 + d0, gt_);
      u32x4 o0, o1; float r[16];
#pragma unroll
      for (int i = 0; i < 16; ++i) r[i] = v[i] * rstd * gn[i] * siluf_(gt_[i]);
      o0.x = pk2(r[0], r[1]); o0.y = pk2(r[2], r[3]); o0.z = pk2(r[4], r[5]); o0.w = pk2(r[6], r[7]);
      o1.x = pk2(r[8], r[9]); o1.y = pk2(r[10], r[11]); o1.z = pk2(r[12], r[13]); o1.w = pk2(r[14], r[15]);
      u16* dst = HB + (size_t)(rowbase + t) * 1024 + mixer * 512 + h * 128 + d0;
      *(u32x4*)dst = o0; *(u32x4*)(dst + 8) = o1; }
}

#define XB_TMO      128
#define XB_XCNT(j)  (256  + 64 * (j))
#define XB_XSUB(j)  (1280 + 64 * (j))
#define XB_XGEN(j)  (2304 + 64 * (j))
#define XB_TOP      3328
#define XB_TOPGEN   3392
#define XCD_BAR_WORDS 3456
#define XB_SPIN_CAP (1u << 22)
DI unsigned xb_ld(unsigned* p)              { return __hip_atomic_load(p, __ATOMIC_RELAXED, __HIP_MEMORY_SCOPE_AGENT); }
DI unsigned xb_add(unsigned* p, unsigned v) { return __hip_atomic_fetch_add(p, v, __ATOMIC_RELAXED, __HIP_MEMORY_SCOPE_AGENT); }
DI unsigned xb_xcc_id() { return (unsigned)__builtin_amdgcn_s_getreg((3 << 11) | 20) & 0xFu; }
#define XB_SPIN(cond, bar) do { unsigned _sp = 0; while (cond) { __builtin_amdgcn_s_sleep(1); \
    if ((++_sp & 255u) == 0u) { if (xb_ld(&(bar)[XB_TMO])) break; if (_sp > XB_SPIN_CAP) { atomicAdd(&(bar)[XB_TMO], 1u); break; } } } } while (0)
struct XcdBarrier { unsigned* bar; unsigned x; volatile LAS unsigned* st; };
DI XcdBarrier xcd_barrier_post(unsigned* bar, volatile LAS unsigned* st) {
    XcdBarrier b; b.bar = bar; b.x = xb_xcc_id(); b.st = st;
    if (threadIdx.x == 0) (void)xb_add(&bar[XB_XCNT(b.x)], 1u);
    return b;
}
DI void xcd_barrier_complete(unsigned* bar, unsigned x, unsigned& nloc, unsigned& nx) {
    const unsigned G = gridDim.x * gridDim.y * gridDim.z;
    unsigned sum, cnt, mine, sp = 0u;
    for (;;) {
        sum = 0u; cnt = 0u; mine = 0u;
#pragma unroll
        for (unsigned j = 0; j < 16; ++j) { const unsigned c = xb_ld(&bar[XB_XCNT(j)]); sum += c; cnt += (c > 0u) ? 1u : 0u; mine = (j == x) ? c : mine; }
        if (sum == G) break;
        __builtin_amdgcn_s_sleep(1);
        if ((++sp & 255u) == 0u) { if (xb_ld(&bar[XB_TMO])) break; if (sp > XB_SPIN_CAP) { atomicAdd(&bar[XB_TMO], 1u); break; } }
    }
    nloc = mine > 0u ? mine : 1u; nx = cnt > 0u ? cnt : 1u;
}
DI void xcd_barrier(const XcdBarrier& b) {
    asm volatile("s_waitcnt vmcnt(0)" ::: "memory");
    __syncthreads();
    if (threadIdx.x == 0) {
        unsigned* bar = b.bar;
        __builtin_amdgcn_s_waitcnt(0);
        unsigned nloc = b.st[0], nx = b.st[1];
        if (nloc == 0u) { xcd_barrier_complete(bar, b.x, nloc, nx); b.st[0] = nloc; b.st[1] = nx; }
        const unsigned old = xb_add(&bar[XB_XSUB(b.x)], 1u);
        const unsigned gen = old / nloc;
        if (old + 1u == (gen + 1u) * nloc) {
            __builtin_amdgcn_fence(__ATOMIC_RELEASE, "agent");
            asm volatile("s_waitcnt vmcnt(0)" ::: "memory");
            const unsigned og = xb_add(&bar[XB_TOP], 1u);
            const unsigned tg = og / nx;
            if (og + 1u == (tg + 1u) * nx) xb_add(&bar[XB_TOPGEN], 1u);
            else XB_SPIN(xb_ld(&bar[XB_TOPGEN]) == tg, bar);
            __builtin_amdgcn_fence(__ATOMIC_ACQUIRE, "agent");
            xb_add(&bar[XB_XGEN(b.x)], 1u);
            asm volatile("s_waitcnt vmcnt(0)" ::: "memory");
        } else {
            XB_SPIN(xb_ld(&bar[XB_XGEN(b.x)]) == gen, bar);
            __builtin_amdgcn_fence(__ATOMIC_ACQUIRE, "agent");
            asm volatile("s_waitcnt vmcnt(0)" ::: "memory");
        }
    }
    __syncthreads();
}

__global__ void __launch_bounds__(512) fwd_megakernel(Params p0) {
    Params p = p0;
    extern __shared__ __attribute__((aligned(16))) unsigned char lds_raw[];
    LAS unsigned char* lds = (LAS unsigned char*)lds_raw;
    cg::grid_group grid = cg::this_grid();
    volatile LAS unsigned* xst = (volatile LAS unsigned*)(lds + 147440);
    if (threadIdx.x < 4) xst[threadIdx.x] = 0u;
    __syncthreads();
    const XcdBarrier xb = xcd_barrier_post((unsigned*)(p.ws + OFF_BAR), xst);
#define GSYNC() do { for (int r_ = 0; r_ < REP(1); ++r_) xcd_barrier(xb); } while (0)
    unsigned char* ws = p.ws;
    float* mod = (float*)(ws + OFF_MOD);
    float* XRES = (float*)(ws + OFF_XRES);
    u16* HB = (u16*)(ws + OFF_HB);
    unsigned char* BIG = ws + OFF_BIG;
    const int G = gridDim.x, bid = blockIdx.x;

    for (int r_ = 0; r_ < REP(32); ++r_) prep_phase(p, (float*)lds_raw);
    if (p.ws == nullptr) grid.sync();
    GSYNC();
    { const float* mp = (const float*)(p.ws + OFF_MODP); float* md = (float*)(p.ws + OFF_MOD);
      for (int i = bid * 512 + tidx(); i < 4 * 3 * 6144; i += G * 512) { float a = 0.f;
#pragma unroll
        for (int k = 0; k < 16; ++k) a += mp[(size_t)k * (4 * 3 * 6144) + i];
        md[i] = a; } }
    GSYNC();

    for (int li = 0; li < 4; ++li) {
        asm volatile("" : "+s"(p.ws));
        ws = p.ws; mod = (float*)(ws + OFF_MOD); XRES = (float*)(ws + OFF_XRES); HB = (u16*)(ws + OFF_HB); BIG = ws + OFF_BIG;
        const float* srcLat = li == 0 ? p.in[0] : XRES;
        const float* srcCtx = li == 0 ? p.in[2] : XRES + (size_t)NLAT * 1024;
        const float* modl = mod + li * 3 * 6144;
        const int j = li >> 1;
        for (int r_ = 0; r_ < REP(16); ++r_) { norm_rows(srcLat, srcCtx, p.in[6] + li * 1024, modl, 1024, 0, HB, li > 0 ? (float*)(BIG + 150000000) : nullptr, 11, mod + (li - 1) * 3 * 6144 + 2 * 6144 + 5 * 1024, XRES);
        conv_ffn_weights(p, li, (float*)lds_raw); }
        GSYNC();
        if ((li & 1) == 0) {
            float* ssq = (float*)(ws + OFF_SSQ); float* sskv = ssq + (size_t)NTOK * 8;
            u16* U = (u16*)(BIG + BE_U); u16* CQKV = (u16*)(BIG + BE_CQKV); u16* Q = (u16*)(BIG + BE_Q); u16* KC = (u16*)(BIG + BE_KC); u16* VT = (u16*)(BIG + BE_VT); u16* Z = (u16*)(BIG + BE_Z);
            { EpiInEven E{U, CQKV, KC, ssq, sskv, (const float*)(ws + OFF_RMLA)};
              run_gemm(lds, HB, 1024, (const u16*)(ws + OFF_WMIX + WE_IN), 1024, NTOK, 1024, 1024, E);
              if (REP(2) > 1) { EpiInEven E2{U, CQKV, KC, (float*)(BIG + 150000000), (float*)(BIG + 150000000), (const float*)(ws + OFF_RMLA)}; run_gemm(lds, HB, 1024, (const u16*)(ws + OFF_WMIX + WE_IN), 1024, NTOK, 1024, 1024, E2); } }
            GSYNC();
            for (int r_ = 0; r_ < REP(8); ++r_) for (int u = bid; u < 2 * NCH * 4; u += G) s5_pass1_unit(p, j, u, lds_raw);
            GSYNC();
            s5_carry_scan(p, j, G > 16 ? G - 16 : 0);
            { EpiQ E{Q, ssq, (const float*)(ws + OFF_RMLA)};
              for (int r_ = 0; r_ < REP(2); ++r_) run_gemm(lds, CQKV, 384, (const u16*)(ws + OFF_WMIX + WE_UQ), 256, NTOK, 768, 256, E); }
            { EpiKV E{KC, VT, sskv};
              for (int r_ = 0; r_ < REP(2); ++r_) run_gemm(lds, CQKV + 128, 384, (const u16*)(ws + OFF_WMIX + WE_UKV), 256, NTOK, 1024, 256, E); }
            GSYNC();
            for (int r_ = 0; r_ < 2; ++r_) for (int u = bid; u < 272 + 1056; u += G) {
                if (r_ == 1 && !(u < 272 ? REP(4) > 1 : REP(8) > 1)) continue;
                if (u < 256) { const int bh = (u & 7) * 2 + (u >> 7), qb = (u >> 3) & 15;
                    __syncthreads();
                    attn_unit64(lds, Q + ((size_t)bh * SEQ + qb * 512) * 96, KC + (size_t)bh * LK * 96, VT + (size_t)bh * 64 * LK, LK / 64,
                                HB + (size_t)((bh >> 3) * SEQ + qb * 512) * 1024 + 512 + (bh & 7) * 64);
                } else if (u < 272) { const int bh = u - 256;
                    __syncthreads();
                    attn_unit(lds, Q + (size_t)NLAT * 768 + (size_t)bh * CTXL * 96, KC + (size_t)bh * LK * 96, VT + (size_t)bh * 64 * LK, CTXL / 64,
                              HB + (size_t)(NLAT + (bh >> 3) * CTXL) * 1024 + 512 + (bh & 7) * 64);
                } else s5_pass2_unit(p, j, u - 272, lds_raw);
            }
            GSYNC();
            { EpiGlu E{Z, HB};
              for (int r_ = 0; r_ < REP(2); ++r_) run_gemm(lds, Z, 512, (const u16*)(ws + OFF_WMIX + WE_GLU), 512, NTOK, 512, 512, E); }
            GSYNC();
            { EpiRes E{srcLat, srcCtx, modl + 2048, XRES, (float*)(BIG + 150000000)};
              run_gemm_mixed(lds, HB, 1024, (const u16*)(ws + OFF_WMIX + WE_OUT), 1024, 1024, 1024, E);
              if (REP(2) > 1) { EpiRes E2{srcLat, srcCtx, modl + 2048, (float*)(BIG + 150000000), (float*)(BIG + 150000000)}; run_gemm(lds, HB, 1024, (const u16*)(ws + OFF_WMIX + WE_OUT), 1024, NTOK, 1024, 1024, E2); } }
            GSYNC();
        } else {
            u16* PROJ = (u16*)(BIG + BO_PROJ);
            { EpiInOdd E{PROJ, (const float*)(ws + OFF_RRET)};
              for (int r_ = 0; r_ < REP(2); ++r_) run_gemm(lds, HB, 1024, (const u16*)(ws + OFF_WMIX + WO_IN), 1024, NTOK, 4608, 1024, E); }
            GSYNC();
            for (int b = 0; b < 2; ++b) {
                for (int r_ = 0; r_ < REP(64); ++r_) for (int u = bid; u < 16 * NCH; u += G) gla_pass1_unit(p, b, j, u, lds_raw);
                GSYNC();
                gla_scan(p);
                GSYNC();
                for (int r_ = 0; r_ < REP(128); ++r_) for (int u = bid; u < 8 * (li == 3 ? 128 : NCH); u += G) gla_pass3_unit(p, b, j, j, u, lds_raw, li == 3);
                GSYNC();
            }
            { EpiRes E{srcLat, srcCtx, modl + 2048, XRES, (float*)(BIG + 150000000)};
              { if (li == 3) run_gemm(lds, HB, 1024, (const u16*)(ws + OFF_WMIX + WO_OUT), 1024, NLAT, 1024, 1024, E); else run_gemm_mixed(lds, HB, 1024, (const u16*)(ws + OFF_WMIX + WO_OUT), 1024, 1024, 1024, E); }
              if (REP(2) > 1) { EpiRes E2{srcLat, srcCtx, modl + 2048, (float*)(BIG + 150000000), (float*)(BIG + 150000000)}; run_gemm(lds, HB, 1024, (const u16*)(ws + OFF_WMIX + WO_OUT), 1024, NTOK, 1024, 1024, E2); } }
            GSYNC();
        }
        for (int r_ = 0; r_ < REP(16); ++r_) { norm_rows(XRES, srcCtx, p.in[7] + li * 1024, modl, 4 * 1024, 3 * 1024, HB, li < 3 ? (float*)(BIG + 150000000) : nullptr, 4, modl + 2 * 6144 + 2048, XRES);
        if (li < 3) conv_mixer_weights(p, li + 1, (float*)lds_raw); }
        GSYNC();
        { EpiFFN1 E{(u16*)(BIG)};
          for (int r_ = 0; r_ < REP(2); ++r_) { if (li == 3) run_gemm(lds, HB, 1024, (const u16*)(ws + OFF_WFFN + WF_13), 1024, NLAT, 5632, 1024, E); else run_gemm(lds, HB, 1024, (const u16*)(ws + OFF_WFFN + WF_13), 1024, NTOK, 5632, 1024, E); } }
        GSYNC();
        { EpiRes E{XRES, XRES + (size_t)NLAT * 1024, modl + 5 * 1024, XRES, (float*)(BIG + 150000000)};
          { if (li == 3) run_gemm(lds, (const u16*)BIG, DFF, (const u16*)(ws + OFF_WFFN + WF_2), DFF, NLAT, 1024, DFF, E); else run_gemm_mixed(lds, (const u16*)BIG, DFF, (const u16*)(ws + OFF_WFFN + WF_2), DFF, 1024, DFF, E); }
          if (REP(2) > 1) { EpiRes E2{XRES, XRES + (size_t)NLAT * 1024, modl + 5 * 1024, (float*)(BIG + 150000000), (float*)(BIG + 150000000)}; run_gemm(lds, (const u16*)BIG, DFF, (const u16*)(ws + OFF_WFFN + WF_2), DFF, NTOK, 1024, DFF, E2); } }
        GSYNC();
    }
    final_norm_rows(XRES, p.in[31], p.out);
}

extern "C" void kernel_launch(void* const* d_in, const int* in_sizes, int n_in, void* d_out, int out_size,
                              void* d_ws, size_t ws_size, hipStream_t stream) {
    constexpr size_t kDynLds = 147456;
    static int grid_blocks = 0;
    if (!grid_blocks) {
        int dev = 0, cus = 0, per_cu = 0;
        (void)hipGetDevice(&dev);
        (void)hipDeviceGetAttribute(&cus, hipDeviceAttributeMultiprocessorCount, dev);
        (void)hipFuncSetAttribute((const void*)fwd_megakernel, hipFuncAttributeMaxDynamicSharedMemorySize, (int)kDynLds);
        (void)hipOccupancyMaxActiveBlocksPerMultiprocessor(&per_cu, fwd_megakernel, 512, kDynLds);
        if (per_cu > 1) per_cu = 1;
        grid_blocks = cus * per_cu;
        if (ws_size < WS_NEED) fprintf(stderr, "workspace too small: %zu < %zu\n", ws_size, (size_t)WS_NEED);
    }
    Params p{};
    for (int i = 0; i < 32; ++i) p.in[i] = (const float*)d_in[i];
    p.out = (float*)d_out; p.ws = (unsigned char*)d_ws;
    (void)hipMemsetAsync((unsigned char*)d_ws + OFF_BAR, 0, 16384, stream);
    void* args[] = {&p};
    hipError_t e = hipLaunchCooperativeKernel((void*)fwd_megakernel, dim3(grid_blocks), dim3(512), args, kDynLds, stream);
    if (e != hipSuccess) fprintf(stderr, "cooperative launch failed: %s (grid %d)\n", hipGetErrorString(e), grid_blocks);
}
```
